# Optimizing an MI355X kernel written in HIP

```python
import jax, jax.numpy as jnp
from jax import lax
import numpy as np

D_MODEL = 1024
BATCH = 8
SEQ = 4096
DEPTH = 1
DEC_BATCH = 32
DEC_SEQ = 32
PAST_LEN = 2048

CHUNK = 64
Q_BLOCK = 128
HEAD_DIM = 64
N_HEADS_A = 8
N_HEADS_B = 8
WIDTH_A = N_HEADS_A * HEAD_DIM
WIDTH_B = N_HEADS_B * HEAD_DIM
IDX_HEADS = 8
IDX_DIM = 64
TOPK_MAX = 256
ROPE_THETA = 500000.0
EPS = 1e-6
NEG_INF = -1e30
D_IN = 4 * WIDTH_A + IDX_HEADS * IDX_DIM + IDX_DIM + IDX_HEADS + 4 * WIDTH_B + 2 * D_MODEL

kernel_name = "dsa_stickbreaking_gated_hybrid_step"


def _split_points():
    sizes = [WIDTH_A] * 4 + [IDX_HEADS * IDX_DIM, IDX_DIM, IDX_HEADS] + [WIDTH_B] * 4 + [D_MODEL, D_MODEL]
    return [int(s) for s in np.cumsum(sizes)[:-1]]


def _rms_norm(x, g):
    xf = x.astype(jnp.float32)
    y = xf * lax.rsqrt(jnp.mean(xf * xf, axis=-1, keepdims=True) + EPS) * g.astype(jnp.float32)
    return y.astype(x.dtype)


def _rope(x, pos):
    rot = x.shape[-1] // 4
    half = rot // 2
    inv_freq = ROPE_THETA ** (-jnp.arange(half, dtype=jnp.float32) / half)
    ang = pos.astype(jnp.float32)[:, None] * inv_freq[None, :]
    cos = jnp.cos(ang)[:, None, :]
    sin = jnp.sin(ang)[:, None, :]
    xr = x[..., :rot].astype(jnp.float32)
    x1, x2 = xr[..., :half], xr[..., half:]
    rotated = jnp.concatenate([x1 * cos - x2 * sin, x2 * cos + x1 * sin], axis=-1).astype(x.dtype)
    return jnp.concatenate([rotated, x[..., rot:]], axis=-1)


def _project(x, pos, norm_g, w_in, q_norm_g, k_norm_g, idx_k_norm_g):
    B, T, _ = x.shape
    xn = _rms_norm(x, norm_g)
    h = jnp.einsum('btd,de->bte', xn, w_in)
    qa, ka, va, ua, qi, ki, wi, qb, kb, vb, ub, ga, gb = jnp.split(h, _split_points(), axis=-1)
    qa = _rope(_rms_norm(qa.reshape(B, T, N_HEADS_A, HEAD_DIM), q_norm_g), pos)
    ka = _rope(_rms_norm(ka.reshape(B, T, N_HEADS_A, HEAD_DIM), k_norm_g), pos)
    va = va.reshape(B, T, N_HEADS_A, HEAD_DIM)
    qi = _rope(qi.reshape(B, T, IDX_HEADS, IDX_DIM), pos)
    ki = _rope(_rms_norm(ki, idx_k_norm_g)[:, :, None, :], pos)[:, :, 0, :]
    wi = wi * (IDX_HEADS ** -0.5)
    qb = qb.reshape(B, T, N_HEADS_B, HEAD_DIM)
    kb = kb.reshape(B, T, N_HEADS_B, HEAD_DIM)
    vb = vb.reshape(B, T, N_HEADS_B, HEAD_DIM)
    return qa, ka, va, ua, qi, ki, wi, qb, kb, vb, ub, ga, gb


def _dsa_block(q, qi, wi, q_pos, k, v, ki, topk):
    S = k.shape[1]
    key_pos = jnp.arange(S, dtype=jnp.int32)
    limit = (q_pos // CHUNK + 1) * CHUNK
    admissible = key_pos[None, :] < limit[:, None]
    dots = jnp.einsum('bqhd,bsd->bqhs', qi.astype(jnp.float32), ki.astype(jnp.float32)) * (IDX_DIM ** -0.5)
    score = jnp.einsum('bqhs,bqh->bqs', jax.nn.relu(dots), wi.astype(jnp.float32))
    score = jnp.where(admissible[None], score, NEG_INF)
    _, idx = lax.top_k(score, topk)
    k_sel = jax.vmap(lambda kk, ii: kk[ii])(k, idx)
    v_sel = jax.vmap(lambda vv, ii: vv[ii])(v, idx)
    ok = idx < limit[None, :, None]
    logits = jnp.einsum('bqhd,bqkhd->bqhk', q.astype(jnp.float32), k_sel.astype(jnp.float32)) * (HEAD_DIM ** -0.5)
    logits = jnp.where(ok[:, :, None, :], logits, NEG_INF)
    p = jax.nn.softmax(logits, axis=-1)
    o = jnp.einsum('bqhk,bqkhd->bqhd', p, v_sel.astype(jnp.float32))
    return o.astype(q.dtype)


def _sb_block(q, q_pos, k, v):
    S = k.shape[1]
    key_pos = jnp.arange(S, dtype=jnp.int32)
    strict = (key_pos[None, :] < q_pos[:, None])[None, None]
    z = jnp.einsum('bqhd,bshd->bhqs', q.astype(jnp.float32), k.astype(jnp.float32)) * (HEAD_DIM ** -0.5)
    log1m = jnp.where(strict, jax.nn.log_sigmoid(-z), 0.0)
    after = lax.cumsum(log1m, axis=3, reverse=True) - log1m
    a = jnp.where(strict, jnp.exp(jax.nn.log_sigmoid(z) + after), 0.0)
    o = jnp.einsum('bhqs,bshd->bqhd', a, v.astype(jnp.float32))
    return o.astype(q.dtype)


def _sweep(fn, q_args, pos):
    B, T = q_args[0].shape[:2]
    nb = T // Q_BLOCK
    blk = lambda a: jnp.moveaxis(a.reshape(B, nb, Q_BLOCK, *a.shape[2:]), 1, 0)
    out = lax.map(lambda args: fn(*args), tuple(blk(a) for a in q_args) + (pos.reshape(nb, Q_BLOCK),))
    return jnp.moveaxis(out, 0, 1).reshape(B, T, *out.shape[3:])


def _layer(x, pos, past, topk, blocked, norm_g, w_in, q_norm_g, k_norm_g, idx_k_norm_g, w_a_out, w_b_out, w_o):
    B, T, _ = x.shape
    qa, ka, va, ua, qi, ki, wi, qb, kb, vb, ub, ga, gb = _project(x, pos, norm_g, w_in, q_norm_g, k_norm_g, idx_k_norm_g)
    new_rows = (ka, va, ki, kb, vb)
    if past is None:
        ka_all, va_all, ki_all, kb_all, vb_all = new_rows
    else:
        ka_all, va_all, ki_all, kb_all, vb_all = [jnp.concatenate([c.astype(n.dtype), n], axis=1) for c, n in zip(past, new_rows)]
    fa = lambda q_, qi_, wi_, p_: _dsa_block(q_, qi_, wi_, p_, ka_all, va_all, ki_all, topk)
    fb = lambda q_, p_: _sb_block(q_, p_, kb_all, vb_all)
    if blocked:
        oa = _sweep(fa, (qa, qi, wi), pos)
        ob = _sweep(fb, (qb,), pos)
    else:
        oa = fa(qa, qi, wi, pos)
        ob = fb(qb, pos)
    ya = jnp.einsum('bte,ed->btd', oa.reshape(B, T, WIDTH_A) * jax.nn.silu(ua), w_a_out)
    yb = jnp.einsum('bte,ed->btd', ob.reshape(B, T, WIDTH_B) * jax.nn.silu(ub), w_b_out)
    mixed = jax.nn.sigmoid(ga) * ya + jax.nn.sigmoid(gb) * yb
    y = x + jnp.einsum('btd,de->bte', mixed, w_o)
    return y, new_rows


def setup_inputs(seed: int = 0) -> dict:
    key = jax.random.key(seed)
    ks = jax.random.split(key, 16)
    nrm = lambda k, shape, scale: jax.random.normal(k, shape, jnp.float32) * scale
    return {
        "x_prompt": nrm(ks[0], (BATCH, SEQ, D_MODEL), 1.0),
        "x_sample": nrm(ks[1], (DEC_BATCH, DEC_SEQ, D_MODEL), 1.0),
        "cache_a_k": nrm(ks[2], (DEPTH, DEC_BATCH, PAST_LEN, N_HEADS_A, HEAD_DIM), 1.0),
        "cache_a_v": nrm(ks[3], (DEPTH, DEC_BATCH, PAST_LEN, N_HEADS_A, HEAD_DIM), 1.0),
        "cache_idx_k": nrm(ks[4], (DEPTH, DEC_BATCH, PAST_LEN, IDX_DIM), 1.0),
        "cache_b_k": nrm(ks[5], (DEPTH, DEC_BATCH, PAST_LEN, N_HEADS_B, HEAD_DIM), 1.0),
        "cache_b_v": nrm(ks[6], (DEPTH, DEC_BATCH, PAST_LEN, N_HEADS_B, HEAD_DIM), 1.0),
        "norm_g": 1.0 + nrm(ks[7], (DEPTH, D_MODEL), 0.02),
        "w_in": nrm(ks[8], (DEPTH, D_MODEL, D_IN), D_MODEL ** -0.5),
        "q_norm_g": 1.0 + nrm(ks[9], (DEPTH, HEAD_DIM), 0.02),
        "k_norm_g": 1.0 + nrm(ks[10], (DEPTH, HEAD_DIM), 0.02),
        "idx_k_norm_g": 1.0 + nrm(ks[11], (DEPTH, IDX_DIM), 0.02),
        "w_a_out": nrm(ks[12], (DEPTH, WIDTH_A, D_MODEL), WIDTH_A ** -0.5),
        "w_b_out": nrm(ks[13], (DEPTH, WIDTH_B, D_MODEL), WIDTH_B ** -0.5),
        "w_o": nrm(ks[14], (DEPTH, D_MODEL, D_MODEL), D_MODEL ** -0.5),
    }


def reference(x_prompt, x_sample, cache_a_k, cache_a_v, cache_idx_k, cache_b_k, cache_b_v,
              norm_g, w_in, q_norm_g, k_norm_g, idx_k_norm_g, w_a_out, w_b_out, w_o):
    seq = x_prompt.shape[1]
    past_len = cache_a_k.shape[2]
    dec_seq = x_sample.shape[1]
    pos_p = jnp.arange(seq, dtype=jnp.int32)
    pos_s = past_len + jnp.arange(dec_seq, dtype=jnp.int32)
    topk_p = min(TOPK_MAX, seq // 4)
    topk_s = min(TOPK_MAX, (past_len + dec_seq) // 4)
    yp, ys = x_prompt, x_sample
    new_p, new_s = [], []
    for l in range(DEPTH):
        params = (norm_g[l], w_in[l], q_norm_g[l], k_norm_g[l], idx_k_norm_g[l], w_a_out[l], w_b_out[l], w_o[l])
        yp, rows_p = _layer(yp, pos_p, None, topk_p, True, *params)
        past = (cache_a_k[l], cache_a_v[l], cache_idx_k[l], cache_b_k[l], cache_b_v[l])
        ys, rows_s = _layer(ys, pos_s, past, topk_s, False, *params)
        new_p.append(rows_p)
        new_s.append(rows_s)
    stk = lambda rows, i: jnp.stack([r[i] for r in rows], axis=0)
    return (yp, ys,
            stk(new_p, 0), stk(new_p, 1), stk(new_p, 2), stk(new_p, 3), stk(new_p, 4),
            stk(new_s, 0), stk(new_s, 1), stk(new_s, 2), stk(new_s, 3), stk(new_s, 4))
```

```cpp
#include <hip/hip_runtime.h>
#include <hip/hip_cooperative_groups.h>
#include <cstdio>
#include <cstdint>
namespace cg = cooperative_groups;

#define DEVI __device__ __forceinline__
typedef unsigned short bf16_t;
typedef short bf16x8 __attribute__((ext_vector_type(8)));
typedef float f32x4 __attribute__((ext_vector_type(4)));
typedef unsigned u32x4 __attribute__((ext_vector_type(4)));
typedef unsigned u32x2 __attribute__((ext_vector_type(2)));

constexpr int NTP = 32768, NTS = 1024, NTOK = 33792;
constexpr int NIN = 6728, NPADC = 6912;
constexpr int NTHREADS = 512;
constexpr size_t O_AKP = 34603008, O_AVP = 51380224, O_IKP = 68157440, O_BKP = 70254592, O_BVP = 87031808;
constexpr size_t O_AKS = 103809024, O_AVS = 104333312, O_IKS = 104857600, O_BKS = 104923136, O_BVS = 105447424;
constexpr size_t SZ_TOK1024 = (size_t)NTOK * 1024 * 2, SZ_TOK512 = (size_t)NTOK * 512 * 2, SZ_P512 = (size_t)NTP * 512 * 2;
constexpr size_t W_XN = 0;
constexpr size_t W_WINT = W_XN + SZ_TOK1024;
constexpr size_t W_WABT = W_WINT + (size_t)NPADC * 1024 * 2;
constexpr size_t W_WOT = W_WABT + 1024 * 1024 * 2;
constexpr size_t W_ROPE = W_WOT + 1024 * 1024 * 2;
constexpr size_t W_QA = W_ROPE + 4096 * 8 * 4 * 2;
constexpr size_t W_SUA = W_QA + SZ_TOK512;
constexpr size_t W_QI = W_SUA + SZ_TOK512;
constexpr size_t W_QB = W_QI + SZ_TOK512;
constexpr size_t W_SUB = W_QB + SZ_TOK512;
constexpr size_t W_WI = W_SUB + SZ_TOK512;
constexpr size_t W_KAP = W_WI + (size_t)NTOK * 8 * 4;
constexpr size_t W_VAP = W_KAP + SZ_P512;
constexpr size_t W_KBP = W_VAP + SZ_P512;
constexpr size_t W_VBP = W_KBP + SZ_P512;
constexpr size_t W_KIP = W_VBP + SZ_P512;
constexpr size_t W_MASK = W_KIP + (size_t)NTP * 64 * 2;
constexpr size_t W_OAB = W_MASK + (size_t)NTOK * 256 * 2;
constexpr size_t W_BAR = W_OAB + SZ_TOK1024;
constexpr size_t W_END = W_BAR + 16384;

constexpr int LDS_XB = 16 * 1040 + 16 * 2052 * 4;
constexpr int LDS_BYTES = LDS_XB + 16;

struct Params {
    const float *x_p, *x_s, *ca_k, *ca_v, *c_ik, *cb_k, *cb_v, *norm_g, *w_in, *qn_g, *kn_g, *ikn_g, *w_a, *w_b, *w_o;
    float* out;
    unsigned char* ws;
};

typedef float f32x2_t __attribute__((ext_vector_type(2)));
typedef __bf16 bf16x2_t __attribute__((ext_vector_type(2)));
DEVI unsigned pk_bf16(float lo, float hi) { const f32x2_t v = {lo, hi}; const bf16x2_t b = __builtin_convertvector(v, bf16x2_t); return __builtin_bit_cast(unsigned, b); }
DEVI float bf_lo(unsigned u) { return __uint_as_float(u << 16); }
DEVI float bf_hi(unsigned u) { return __uint_as_float(u & 0xffff0000u); }
DEVI float shx(float v, int m) { return __shfl_xor(v, m); }
DEVI f32x4 mfma16(bf16x8 a, bf16x8 b, f32x4 c) { return __builtin_amdgcn_mfma_f32_16x16x32_bf16(a, b, c, 0, 0, 0); }
DEVI float relu_(float x) { const int b = __float_as_int(x); return __int_as_float(b > 0 ? b : 0); }
DEVI float sigmoidf_(float x) { return __builtin_amdgcn_rcpf(1.0f + __expf(-x)); }
DEVI int tok_pos(int tok) { return tok < NTP ? (tok & 4095) : 2048 + ((tok - NTP) & 31); }

DEVI void transpose_job(const float* src, int lds, int k0, int ncol0, int nvalid, bf16_t* dst, int dstK, int drow0, int permslab, float* T, int lane) {
    const int r = lane >> 4, c4 = lane & 15;
    float4 v[8];
#pragma unroll
    for (int j = 0; j < 8; ++j) {
        v[j] = make_float4(0.f, 0.f, 0.f, 0.f);
        if (4 * c4 < nvalid) v[j] = *(const float4*)(src + (size_t)(k0 + r + 4 * j) * lds + ncol0 + 4 * c4);
    }
#pragma unroll
    for (int j = 0; j < 8; ++j) { float* t = T + (r + 4 * j) * 65 + 4 * c4; t[0] = v[j].x; t[1] = v[j].y; t[2] = v[j].z; t[3] = v[j].w; }
    __builtin_amdgcn_wave_barrier();
    asm volatile("s_waitcnt lgkmcnt(0)" ::: "memory");
    const int n = lane;
    const int drow = (permslab < 0) ? (drow0 + n) : (256 * (permslab >> 2) + 128 * (n >> 5) + 32 * (permslab & 3) + (n & 31));
    bf16_t* dp = dst + (size_t)drow * dstK + k0;
#pragma unroll
    for (int q = 0; q < 4; ++q) {
        float e[8];
#pragma unroll
        for (int i = 0; i < 8; ++i) e[i] = T[(8 * q + i) * 65 + n];
        u32x4 o; o.x = pk_bf16(e[0], e[1]); o.y = pk_bf16(e[2], e[3]); o.z = pk_bf16(e[4], e[5]); o.w = pk_bf16(e[6], e[7]);
        *(u32x4*)(dp + 8 * q) = o;
    }
    __builtin_amdgcn_wave_barrier();
    asm volatile("s_waitcnt lgkmcnt(0)" ::: "memory");
}

DEVI void phase0(const Params& p, unsigned char* smem) {
    int tid = threadIdx.x; asm volatile("" : "+v"(tid));
    const int lane = tid & 63, wave = tid >> 6;
    bf16_t* XN = (bf16_t*)(p.ws + W_XN);
    const int rstep = gridDim.x * 8;
    for (int row = blockIdx.x * 8 + wave; row < NTOK; row += 2 * rstep) {
        const int row2 = row + rstep;
        const bool has2 = row2 < NTOK;
        const float* xa = (row < NTP) ? p.x_p + (size_t)row * 1024 : p.x_s + (size_t)(row - NTP) * 1024;
        const int r2c = has2 ? row2 : row;
        const float* xb = (r2c < NTP) ? p.x_p + (size_t)r2c * 1024 : p.x_s + (size_t)(r2c - NTP) * 1024;
        float4 va[4], vb[4]; float sa = 0.f, sb = 0.f;
#pragma unroll
        for (int i = 0; i < 4; ++i) { va[i] = *(const float4*)(xa + i * 256 + lane * 4); vb[i] = *(const float4*)(xb + i * 256 + lane * 4); }
#pragma unroll
        for (int i = 0; i < 4; ++i) { sa += va[i].x * va[i].x + va[i].y * va[i].y + va[i].z * va[i].z + va[i].w * va[i].w; sb += vb[i].x * vb[i].x + vb[i].y * vb[i].y + vb[i].z * vb[i].z + vb[i].w * vb[i].w; }
#pragma unroll
        for (int m = 32; m >= 1; m >>= 1) { sa += shx(sa, m); sb += shx(sb, m); }
        const float ra = rsqrtf(sa * (1.0f / 1024.0f) + 1e-6f), rb = rsqrtf(sb * (1.0f / 1024.0f) + 1e-6f);
#pragma unroll
        for (int i = 0; i < 4; ++i) {
            const float4 gg = *(const float4*)(p.norm_g + i * 256 + lane * 4);
            u32x2 o; o.x = pk_bf16(va[i].x * ra * gg.x, va[i].y * ra * gg.y); o.y = pk_bf16(va[i].z * ra * gg.z, va[i].w * ra * gg.w);
            *(u32x2*)(XN + (size_t)row * 1024 + i * 256 + lane * 4) = o;
            if (has2) { u32x2 o2; o2.x = pk_bf16(vb[i].x * rb * gg.x, vb[i].y * rb * gg.y); o2.y = pk_bf16(vb[i].z * rb * gg.z, vb[i].w * rb * gg.w);
                *(u32x2*)(XN + (size_t)row2 * 1024 + i * 256 + lane * 4) = o2; }
        }
    }
    bf16_t* WINT = (bf16_t*)(p.ws + W_WINT); bf16_t* WAT = (bf16_t*)(p.ws + W_WABT); bf16_t* WBT = WAT + 1024 * 512; bf16_t* WOT = (bf16_t*)(p.ws + W_WOT);
    float* T = (float*)smem + wave * (32 * 65);
    const int NJ_IN = 32 * 106, NJ_A = 16 * 16, NJ_O = 32 * 16;
    for (int job = blockIdx.x * 8 + wave; job < NJ_IN + 2 * NJ_A + NJ_O; job += gridDim.x * 8) {
        if (job < NJ_IN) {
            const int kt = job & 31, sl = job >> 5;
            const int np0 = sl * 64;
            int ncol0, nvalid;
            if (np0 < 2624) { ncol0 = np0; nvalid = 64; }
            else if (np0 == 2624) { ncol0 = 2624; nvalid = 8; }
            else { ncol0 = np0 - 56; nvalid = 64; }
            transpose_job(p.w_in, NIN, kt * 32, ncol0, nvalid, WINT, 1024, 0, sl, T, lane);
        } else if (job < NJ_IN + NJ_A) {
            const int j = job - NJ_IN; const int kt = j & 15, ntl = j >> 4;
            transpose_job(p.w_a, 1024, kt * 32, ntl * 64, 64, WAT, 512, ntl * 64, -1, T, lane);
        } else if (job < NJ_IN + 2 * NJ_A) {
            const int j = job - NJ_IN - NJ_A; const int kt = j & 15, ntl = j >> 4;
            transpose_job(p.w_b, 1024, kt * 32, ntl * 64, 64, WBT, 512, ntl * 64, -1, T, lane);
        } else {
            const int j = job - NJ_IN - 2 * NJ_A; const int kt = j & 31, ntl = j >> 5;
            transpose_job(p.w_o, 1024, kt * 32, ntl * 64, 64, WOT, 1024, ntl * 64, -1, T, lane);
        }
    }
    float* RC = (float*)(p.ws + W_ROPE); float* RS = RC + 4096 * 8;
    for (int idx = (gridDim.x - 1 - blockIdx.x) * NTHREADS + tid; idx < 4096 * 8; idx += gridDim.x * NTHREADS) {
        const int pos = idx >> 3, i = idx & 7;
        const float inv = (i == 0) ? 1.0f : (i == 1) ? 0.19392274f : (i == 2) ? 0.03760603f : (i == 3) ? 0.0072926646f : (i == 4) ? 0.0014142136f : (i == 5) ? 0.0002742482f : (i == 6) ? 5.3182957e-05f : 1.0313385e-05f;
        const float ang = (float)pos * inv;
        RC[idx] = (float)cos((double)ang); RS[idx] = (float)sin((double)ang);
    }
    __syncthreads();
}

namespace pg8 {
#define PG8_LAS __attribute__((address_space(3)))
constexpr int BM = 256, BK = 64, HALF = 128, HTB = HALF * BK * 2, STAGE_BYTES = 8 * HTB;
__host__ __device__ __forceinline__ int lds_byte(int r, int c) { const int st = (r >> 4) * 2 + (c >> 5), rr = r & 15, cc = c & 31, ob = rr * 64 + cc * 2; return st * 1024 + (ob ^ (((ob >> 9) & 1) << 5)); }
__host__ __device__ __forceinline__ void stage_rc(int b, int& R, int& C) { const int st = b / 1024, sb = b % 1024, swz = sb ^ (((sb >> 9) & 1) << 5); R = (st >> 1) * 16 + swz / 64; C = (st & 1) * 32 + (swz % 64) / 2; }
struct Unit { int pm, pn, w; };
struct Gemm { const bf16_t* A; const bf16_t* Bt; const bf16_t* A2; const bf16_t* Bt2; int K; };

template <class Epi, class Sched>
__device__ __forceinline__ void gemm_phase(PG8_LAS unsigned char* lds, const Gemm g, const Sched& S, const Epi& E) {
    int tid = threadIdx.x; asm volatile("" : "+v"(tid));
    const int wid = __builtin_amdgcn_readfirstlane(tid >> 6), lane = tid & 63, wr = wid >> 2, wc = wid & 3, fr = lane & 15, fq = lane >> 4;
    const int K = g.K, nt = K / BK;
    unsigned voffA[2];
#pragma unroll
    for (int i = 0; i < 2; ++i) { int R, C; stage_rc(tid * 16 + i * 8192, R, C); voffA[i] = (unsigned)(R * K + C) * 2u; }
    const size_t kstep = (size_t)(BK * 2);
    const size_t hstep = (size_t)HALF * K * 2;
    const size_t tstep = 2 * hstep;
    const unsigned ldsw = (unsigned)wid * 1024u;
    const int aoff = lds_byte(wr * 64 + fr, fq * 8), boff = lds_byte(wc * 32 + fr, fq * 8);
#define PG8_SA(b, h) (((b) * 2 + (h)) * HTB)
#define PG8_SB(b, h) ((4 + (b) * 2 + (h)) * HTB)
#define PG8_STAGE(bufoff, gbase, voff) do { _Pragma("unroll") for (int _i = 0; _i < 2; ++_i) \
        __builtin_amdgcn_global_load_lds((const unsigned*)((const char*)(gbase) + (voff)[_i]), (PG8_LAS unsigned*)(lds + (bufoff) + ldsw + _i * 8192), 16, 0, 0); } while (0)
#define PG8_LDA(dst, b, h) do { _Pragma("unroll") for (int m = 0; m < 4; ++m) _Pragma("unroll") for (int k = 0; k < 2; ++k) dst[m][k] = *(const PG8_LAS bf16x8*)(lds + PG8_SA(b, h) + aoff + m * 2048 + k * 1024); } while (0)
#define PG8_LDB(dst, b, h) do { _Pragma("unroll") for (int n = 0; n < 2; ++n) _Pragma("unroll") for (int k = 0; k < 2; ++k) dst[n][k] = *(const PG8_LAS bf16x8*)(lds + PG8_SB(b, h) + boff + n * 2048 + k * 1024); } while (0)
#define PG8_MMA(ai, bj, At, Bt) do { __builtin_amdgcn_s_setprio(1); _Pragma("unroll") for (int m = 0; m < 4; ++m) _Pragma("unroll") for (int n = 0; n < 2; ++n) _Pragma("unroll") for (int k = 0; k < 2; ++k) \
        acc[ai][bj][m][n] = __builtin_amdgcn_mfma_f32_16x16x32_bf16(Bt[n][k], At[m][k], acc[ai][bj][m][n], 0, 0, 0); __builtin_amdgcn_s_setprio(0); } while (0)
#define PG8_WAIT_V(n) asm volatile("s_waitcnt vmcnt(" #n ")" ::: "memory")
#define PG8_WAIT_L(n) asm volatile("s_waitcnt lgkmcnt(" #n ")" ::: "memory")
#define PG8_BAR __builtin_amdgcn_s_barrier()
#define PG8_SCHED __builtin_amdgcn_sched_barrier(0)
    Unit cur, nxt; int ui = 0;
    if (!S.next(0, cur)) return;
    f32x4 acc[2][2][4][2];
#pragma unroll
    for (int a = 0; a < 2; ++a)
#pragma unroll
        for (int b = 0; b < 2; ++b)
#pragma unroll
            for (int m = 0; m < 4; ++m)
#pragma unroll
                for (int n = 0; n < 2; ++n) acc[a][b][m][n] = (f32x4){0.f, 0.f, 0.f, 0.f};
    bf16x8 At[4][2], B0[2][2], B1[2][2];
    const char* cA = (const char*)(cur.w ? g.A2 : g.A) + (size_t)cur.pm * tstep; const char* cB = (const char*)(cur.w ? g.Bt2 : g.Bt) + (size_t)cur.pn * tstep;
    PG8_STAGE(PG8_SB(0, 0), cB, voffA); PG8_STAGE(PG8_SB(0, 1), cB + hstep, voffA); PG8_STAGE(PG8_SA(0, 0), cA, voffA); PG8_STAGE(PG8_SA(0, 1), cA + hstep, voffA);
    if (wr == 1) PG8_BAR;
    PG8_WAIT_V(2); PG8_BAR;
    PG8_STAGE(PG8_SB(1, 0), cB + kstep, voffA); PG8_STAGE(PG8_SA(1, 0), cA + kstep, voffA); PG8_STAGE(PG8_SB(1, 1), cB + hstep + kstep, voffA);
    PG8_WAIT_V(6); PG8_BAR;
    for (;;) {
        const bool has_next = S.next(ui + 1, nxt);
        const char* nA = has_next ? (const char*)(nxt.w ? g.A2 : g.A) + (size_t)nxt.pm * tstep : cA; const char* nB = has_next ? (const char*)(nxt.w ? g.Bt2 : g.Bt) + (size_t)nxt.pn * tstep : cB;
        for (int t = 0; t < nt; t += 2) {
            const bool last = (t == nt - 2);
            const char* a1 = cA + (size_t)(t + 1) * kstep;
            const char* a2 = last ? nA : cA + (size_t)(t + 2) * kstep; const char* b2 = last ? nB : cB + (size_t)(t + 2) * kstep;
            const char* a3 = a2 + kstep; const char* b3 = b2 + kstep;
            PG8_LDB(B0, 0, 0); PG8_LDB(B1, 0, 1); PG8_SCHED; PG8_LDA(At, 0, 0); PG8_STAGE(PG8_SA(1, 1), a1 + hstep, voffA);
            PG8_WAIT_V(8); PG8_WAIT_L(0); PG8_BAR; PG8_MMA(0, 0, At, B0); PG8_MMA(0, 1, At, B1); PG8_BAR; PG8_SCHED;
            PG8_LDA(At, 0, 1); PG8_STAGE(PG8_SB(0, 0), b2, voffA); PG8_STAGE(PG8_SB(0, 1), b2 + hstep, voffA); PG8_STAGE(PG8_SA(0, 0), a2, voffA);
            PG8_WAIT_V(8); PG8_WAIT_L(0); PG8_BAR; PG8_MMA(1, 0, At, B0); PG8_MMA(1, 1, At, B1); PG8_BAR; PG8_SCHED;
            PG8_LDB(B0, 1, 0); PG8_LDB(B1, 1, 1); PG8_SCHED; PG8_LDA(At, 1, 0); PG8_STAGE(PG8_SA(0, 1), a2 + hstep, voffA);
            PG8_WAIT_V(8); PG8_WAIT_L(0); PG8_BAR; PG8_MMA(0, 0, At, B0); PG8_MMA(0, 1, At, B1); PG8_BAR; PG8_SCHED;
            PG8_LDA(At, 1, 1); PG8_STAGE(PG8_SB(1, 0), b3, voffA); PG8_STAGE(PG8_SB(1, 1), b3 + hstep, voffA); PG8_STAGE(PG8_SA(1, 0), a3, voffA);
            PG8_WAIT_V(8); PG8_WAIT_L(0); PG8_BAR; PG8_MMA(1, 0, At, B0); PG8_MMA(1, 1, At, B1); PG8_BAR; PG8_SCHED;
        }
        if (wr == 0) PG8_BAR;
        E(acc, cur, wr, wc, fr, fq);
        if (!has_next) break;
#pragma unroll
        for (int a = 0; a < 2; ++a)
#pragma unroll
            for (int b = 0; b < 2; ++b)
#pragma unroll
                for (int m = 0; m < 4; ++m)
#pragma unroll
                    for (int n = 0; n < 2; ++n) acc[a][b][m][n] = (f32x4){0.f, 0.f, 0.f, 0.f};
        cur = nxt; cA = nA; cB = nB; ++ui;
        if (wr == 1) PG8_BAR;
    }
    PG8_WAIT_V(0);
    PG8_BAR;
#undef PG8_SA
#undef PG8_SB
#undef PG8_STAGE
#undef PG8_LDA
#undef PG8_LDB
#undef PG8_MMA
#undef PG8_WAIT_V
#undef PG8_WAIT_L
#undef PG8_BAR
#undef PG8_SCHED
}
}

struct OrderP1 {
    int x, j, nloc, G;
    DEVI void init() { G = gridDim.x; const int b = blockIdx.x; if ((G & 7) == 0) { x = b & 7; j = b >> 3; nloc = G >> 3; } else { x = -1; j = b; nloc = G; } }
    DEVI bool next(int i, pg8::Unit& u) const {
        const int T = 132 * 27;
        int idx;
        if (x >= 0) { const int s0 = (x * T) >> 3, s1 = ((x + 1) * T) >> 3; idx = s0 + i * nloc + j; if (idx >= s1) return false; }
        else { idx = j + i * G; if (idx >= T) return false; }
        const int mg = idx / 108, rem = idx - mg * 108;
        u.pm = mg * 4 + (rem & 3); u.pn = rem >> 2; u.w = 0; return true;
    }
};
struct OrderP4 {
    int x, j, nloc, G; bool pair;
    DEVI void init(bool pr) { pair = pr; G = gridDim.x; const int b = blockIdx.x; if ((G & 7) == 0) { x = b & 7; j = b >> 3; nloc = G >> 3; } else { x = -1; j = b; nloc = G; } }
    DEVI bool next(int i, pg8::Unit& u) const {
        const int T = 128 * 4;
        const int ii = pair ? (i >> 1) : i;
        int idx;
        if (x >= 0) { const int s0 = (x * T) >> 3, s1 = ((x + 1) * T) >> 3; idx = s0 + ii * nloc + j; if (idx >= s1) return false; }
        else { idx = j + ii * G; if (idx >= T) return false; }
        u.pm = idx >> 2; u.pn = idx & 3; u.w = pair ? (i & 1) : 0; return true;
    }
};

struct EpiProj {
    const Params* pp;
    DEVI void operator()(const f32x4 (&acc)[2][2][4][2], const pg8::Unit& u, int wr, int wc, int l15, int g) const {
        const Params& p = *pp;
        const int slab = 4 * u.pn + wc;
        if (slab >= 106) return;
        const int m0 = u.pm * 256;
        const bool prompt = m0 < NTP;
        const int tokb = m0 + 64 * wr + l15;
        if (slab == 41) {
            if (g < 2) {
                float* WI = (float*)(p.ws + W_WI);
#pragma unroll
                for (int ai = 0; ai < 2; ++ai)
#pragma unroll
                    for (int m = 0; m < 4; ++m) {
                        const f32x4 v = acc[ai][0][m][0] * 0.35355339059327373f;
                        *(f32x4*)(WI + (size_t)(tokb + 128 * ai + 16 * m) * 8 + 4 * g) = v;
                    }
            }
            return;
        }
        const float* gain = nullptr; bool rope = false; int act = 0;
        float* fdst = nullptr; int fw = 0; bf16_t* bdst = nullptr; int bw = 512; bool bprompt = false; int colo = 0;
        float oscale = 1.0f;
        if (slab < 8) { gain = p.qn_g; rope = true; bdst = (bf16_t*)(p.ws + W_QA); colo = slab * 64; oscale = 0.125f * 1.4426950408889634f; }
        else if (slab < 16) { gain = p.kn_g; rope = true; fdst = p.out + (prompt ? O_AKP : O_AKS); fw = 512; bdst = (bf16_t*)(p.ws + W_KAP); bprompt = true; colo = (slab - 8) * 64; }
        else if (slab < 24) { fdst = p.out + (prompt ? O_AVP : O_AVS); fw = 512; bdst = (bf16_t*)(p.ws + W_VAP); bprompt = true; colo = (slab - 16) * 64; }
        else if (slab < 32) { act = 1; bdst = (bf16_t*)(p.ws + W_SUA); colo = (slab - 24) * 64; }
        else if (slab < 40) { rope = true; bdst = (bf16_t*)(p.ws + W_QI); colo = (slab - 32) * 64; }
        else if (slab == 40) { gain = p.ikn_g; rope = true; fdst = p.out + (prompt ? O_IKP : O_IKS); fw = 64; bdst = (bf16_t*)(p.ws + W_KIP); bw = 64; bprompt = true; colo = 0; }
        else if (slab < 50) { bdst = (bf16_t*)(p.ws + W_QB); colo = (slab - 42) * 64; oscale = -0.125f * 1.4426950408889634f; }
        else if (slab < 58) { fdst = p.out + (prompt ? O_BKP : O_BKS); fw = 512; bdst = (bf16_t*)(p.ws + W_KBP); bprompt = true; colo = (slab - 50) * 64; }
        else if (slab < 66) { fdst = p.out + (prompt ? O_BVP : O_BVS); fw = 512; bdst = (bf16_t*)(p.ws + W_VBP); bprompt = true; colo = (slab - 58) * 64; }
        else if (slab < 74) { act = 1; bdst = (bf16_t*)(p.ws + W_SUB); colo = (slab - 66) * 64; }
        else if (slab < 90) { act = 2; bdst = (bf16_t*)p.out; bw = 2048; colo = (slab - 74) * 64; }
        else { act = 2; bdst = (bf16_t*)p.out; bw = 2048; colo = 1024 + (slab - 90) * 64; }
        f32x4 gv[4];
        if (gain) {
#pragma unroll
            for (int nt = 0; nt < 4; ++nt) gv[nt] = *(const f32x4*)(gain + 16 * nt + 4 * g);
        }
        const float* RC = (const float*)(p.ws + W_ROPE); const float* RS = RC + 4096 * 8;
        const bool wb = bdst && (!bprompt || prompt);
#pragma unroll
        for (int ai = 0; ai < 2; ++ai) {
        f32x4 ropc[4], rops[4];
        if (rope) {
#pragma unroll
            for (int q = 0; q < 4; ++q) {
                const int pos = tok_pos(tokb + 128 * ai + 16 * q);
                ropc[q] = *(const f32x4*)(RC + pos * 8 + 4 * (g & 1));
                rops[q] = *(const f32x4*)(RS + pos * 8 + 4 * (g & 1));
            }
        }
#pragma unroll
        for (int m = 0; m < 4; ++m) {
            const int tok = tokb + 128 * ai + 16 * m;
            f32x4 v[4];
#pragma unroll
            for (int nt = 0; nt < 4; ++nt) v[nt] = acc[ai][nt >> 1][m][nt & 1];
            if (gain) {
                float ss = 0.f;
#pragma unroll
                for (int nt = 0; nt < 4; ++nt) ss += v[nt][0] * v[nt][0] + v[nt][1] * v[nt][1] + v[nt][2] * v[nt][2] + v[nt][3] * v[nt][3];
                ss += shx(ss, 16); ss += shx(ss, 32);
                const float rs = rsqrtf(ss * (1.0f / 64.0f) + 1e-6f);
#pragma unroll
                for (int nt = 0; nt < 4; ++nt) v[nt] = v[nt] * rs * gv[nt];
            }
            if (rope) {
                const f32x4 c4 = ropc[m], s4 = rops[m];
                f32x4 o;
#pragma unroll
                for (int r = 0; r < 4; ++r) {
                    const float me = v[0][r], pr = shx(me, 32);
                    o[r] = (g < 2) ? (me * c4[r] - pr * s4[r]) : (me * c4[r] + pr * s4[r]);
                }
                v[0] = o;
            }
            if (slab < 8 || (slab >= 42 && slab < 50)) {
#pragma unroll
                for (int nt = 0; nt < 4; ++nt) v[nt] = v[nt] * oscale;
            }
            if (act == 1) {
#pragma unroll
                for (int nt = 0; nt < 4; ++nt)
#pragma unroll
                    for (int r = 0; r < 4; ++r) v[nt][r] = v[nt][r] * sigmoidf_(v[nt][r]);
            } else if (act == 2) {
#pragma unroll
                for (int nt = 0; nt < 4; ++nt)
#pragma unroll
                    for (int r = 0; r < 4; ++r) v[nt][r] = sigmoidf_(v[nt][r]);
            }
            if (fdst) {
                float* fp = fdst + (size_t)(prompt ? tok : tok - NTP) * fw + colo + 4 * g;
#pragma unroll
                for (int nt = 0; nt < 4; ++nt) *(f32x4*)(fp + 16 * nt) = v[nt];
            }
            if (wb) {
                bf16_t* bp = bdst + (size_t)tok * bw + colo + 16 * (g & 1) + 8 * (g >> 1);
#pragma unroll
                for (int pr = 0; pr < 2; ++pr) {
                    const unsigned x0 = pk_bf16(v[2 * pr][0], v[2 * pr][1]), x1 = pk_bf16(v[2 * pr][2], v[2 * pr][3]);
                    const unsigned y0 = pk_bf16(v[2 * pr + 1][0], v[2 * pr + 1][1]), y1 = pk_bf16(v[2 * pr + 1][2], v[2 * pr + 1][3]);
                    const auto r0 = __builtin_amdgcn_permlane16_swap(x0, y0, false, false);
                    const auto r1 = __builtin_amdgcn_permlane16_swap(x1, y1, false, false);
                    const u32x4 o = (u32x4){r0[0], r1[0], r0[1], r1[1]};
                    *(u32x4*)(bp + 32 * pr) = o;
                }
            }
        }
        }
    }
};

struct EpiMix {
    const Params* pp;
    DEVI void operator()(const f32x4 (&acc)[2][2][4][2], const pg8::Unit& u, int wr, int wc, int l15, int g) const {
        const bf16_t* G = (const bf16_t*)pp->out;
        bf16_t* MX = (bf16_t*)(pp->ws + W_XN);
        const int colb = u.pn * 256 + 32 * wc + 4 * g;
#pragma unroll
        for (int ai = 0; ai < 2; ++ai)
#pragma unroll
        for (int mh = 0; mh < 2; ++mh) {
            u32x2 gq[4][2][2], pv[4][2][2];
#pragma unroll
            for (int m = 2 * mh; m < 2 * mh + 2; ++m) {
                const int tok = u.pm * 256 + 128 * ai + 64 * wr + 16 * m + l15;
#pragma unroll
                for (int bj = 0; bj < 2; ++bj)
#pragma unroll
                    for (int n = 0; n < 2; ++n) {
                        const int col = colb + 128 * bj + 16 * n;
                        gq[m][bj][n] = *(const u32x2*)(G + (size_t)tok * 2048 + (u.w ? 1024 : 0) + col);
                        if (u.w) pv[m][bj][n] = *(const u32x2*)(MX + (size_t)tok * 1024 + col);
                    }
            }
#pragma unroll
            for (int m = 2 * mh; m < 2 * mh + 2; ++m) {
                const int tok = u.pm * 256 + 128 * ai + 64 * wr + 16 * m + l15;
#pragma unroll
                for (int bj = 0; bj < 2; ++bj) {
                    unsigned pk[2][2];
#pragma unroll
                    for (int n = 0; n < 2; ++n) {
                        const f32x4 a = acc[ai][bj][m][n];
                        const u32x2 gg = gq[m][bj][n];
                        f32x4 t;
                        t[0] = a[0] * bf_lo(gg.x); t[1] = a[1] * bf_hi(gg.x); t[2] = a[2] * bf_lo(gg.y); t[3] = a[3] * bf_hi(gg.y);
                        if (u.w) { const u32x2 q = pv[m][bj][n]; t[0] += bf_lo(q.x); t[1] += bf_hi(q.x); t[2] += bf_lo(q.y); t[3] += bf_hi(q.y); }
                        pk[n][0] = pk_bf16(t[0], t[1]); pk[n][1] = pk_bf16(t[2], t[3]);
                    }
                    const auto r0 = __builtin_amdgcn_permlane16_swap(pk[0][0], pk[1][0], false, false);
                    const auto r1 = __builtin_amdgcn_permlane16_swap(pk[0][1], pk[1][1], false, false);
                    const u32x4 o = (u32x4){r0[0], r1[0], r0[1], r1[1]};
                    *(u32x4*)(MX + (size_t)tok * 1024 + u.pn * 256 + 32 * wc + 128 * bj + 16 * (g & 1) + 8 * (g >> 1)) = o;
                }
            }
        }
    }
};

struct EpiY {
    const Params* pp;
    DEVI void operator()(const f32x4 (&acc)[2][2][4][2], const pg8::Unit& u, int wr, int wc, int l15, int g) const {
        const int colb = u.pn * 256 + 32 * wc + 4 * g;
#pragma unroll
        for (int ai = 0; ai < 2; ++ai)
#pragma unroll
        for (int mh = 0; mh < 2; ++mh) {
            f32x4 xv[4][2][2];
#pragma unroll
            for (int m = 2 * mh; m < 2 * mh + 2; ++m) {
                const int tok = u.pm * 256 + 128 * ai + 64 * wr + 16 * m + l15;
                const float* xr = (tok < NTP) ? pp->x_p + (size_t)tok * 1024 : pp->x_s + (size_t)(tok - NTP) * 1024;
#pragma unroll
                for (int bj = 0; bj < 2; ++bj)
#pragma unroll
                    for (int n = 0; n < 2; ++n) xv[m][bj][n] = *(const f32x4*)(xr + colb + 128 * bj + 16 * n);
            }
#pragma unroll
            for (int m = 2 * mh; m < 2 * mh + 2; ++m) {
                const int tok = u.pm * 256 + 128 * ai + 64 * wr + 16 * m + l15;
#pragma unroll
                for (int bj = 0; bj < 2; ++bj)
#pragma unroll
                    for (int n = 0; n < 2; ++n) *(f32x4*)(pp->out + (size_t)tok * 1024 + colb + 128 * bj + 16 * n) = xv[m][bj][n] + acc[ai][bj][m][n];
            }
        }
    }
};

DEVI void mini_kloop(const bf16_t* __restrict__ arow, const bf16_t* __restrict__ b0, const bf16_t* __restrict__ b1, const int K, f32x4 (&acc)[2]) {
#pragma unroll 8
    for (int k0 = 0; k0 < K; k0 += 32) {
        const bf16x8 af = *(const bf16x8*)(arow + k0), w0 = *(const bf16x8*)(b0 + k0), w1 = *(const bf16x8*)(b1 + k0);
        acc[0] = mfma16(w0, af, acc[0]); acc[1] = mfma16(w1, af, acc[1]);
    }
}
DEVI void mini_mix_tile(const Params& p, const int t) {
    int tid = threadIdx.x; asm volatile("" : "+v"(tid));
    const int lane = tid & 63, w = tid >> 6, l15 = lane & 15, g = lane >> 4;
    const int tok = NTP + 64 * (t >> 4) + 16 * (w & 3) + l15, colw = 64 * (t & 15) + 32 * (w >> 2);
    const bf16_t* OA = (const bf16_t*)(p.ws + W_OAB); const bf16_t* OB = OA + (size_t)NTOK * 512;
    const bf16_t* WAT = (const bf16_t*)(p.ws + W_WABT); const bf16_t* WBT = WAT + 1024 * 512;
    f32x4 aa[2] = {(f32x4){0.f, 0.f, 0.f, 0.f}, (f32x4){0.f, 0.f, 0.f, 0.f}}, ab[2] = {(f32x4){0.f, 0.f, 0.f, 0.f}, (f32x4){0.f, 0.f, 0.f, 0.f}};
    mini_kloop(OA + (size_t)tok * 512 + 8 * g, WAT + (size_t)(colw + l15) * 512 + 8 * g, WAT + (size_t)(colw + 16 + l15) * 512 + 8 * g, 512, aa);
    mini_kloop(OB + (size_t)tok * 512 + 8 * g, WBT + (size_t)(colw + l15) * 512 + 8 * g, WBT + (size_t)(colw + 16 + l15) * 512 + 8 * g, 512, ab);
    const bf16_t* G = (const bf16_t*)p.out; bf16_t* MX = (bf16_t*)(p.ws + W_XN);
#pragma unroll
    for (int tt = 0; tt < 2; ++tt) {
        const int col = colw + 16 * tt + 4 * g;
        const u32x2 ga = *(const u32x2*)(G + (size_t)tok * 2048 + col), gb = *(const u32x2*)(G + (size_t)tok * 2048 + 1024 + col);
        f32x4 m;
        m[0] = aa[tt][0] * bf_lo(ga.x) + ab[tt][0] * bf_lo(gb.x); m[1] = aa[tt][1] * bf_hi(ga.x) + ab[tt][1] * bf_hi(gb.x);
        m[2] = aa[tt][2] * bf_lo(ga.y) + ab[tt][2] * bf_lo(gb.y); m[3] = aa[tt][3] * bf_hi(ga.y) + ab[tt][3] * bf_hi(gb.y);
        u32x2 o; o.x = pk_bf16(m[0], m[1]); o.y = pk_bf16(m[2], m[3]);
        *(u32x2*)(MX + (size_t)tok * 1024 + col) = o;
    }
}
DEVI void mini_y_tile(const Params& p, const int t) {
    int tid = threadIdx.x; asm volatile("" : "+v"(tid));
    const int lane = tid & 63, w = tid >> 6, l15 = lane & 15, g = lane >> 4;
    const int tok = NTP + 64 * (t >> 4) + 16 * (w & 3) + l15, colw = 64 * (t & 15) + 32 * (w >> 2);
    const bf16_t* MX = (const bf16_t*)(p.ws + W_XN); const bf16_t* WOT = (const bf16_t*)(p.ws + W_WOT);
    f32x4 acc[2] = {(f32x4){0.f, 0.f, 0.f, 0.f}, (f32x4){0.f, 0.f, 0.f, 0.f}};
    mini_kloop(MX + (size_t)tok * 1024 + 8 * g, WOT + (size_t)(colw + l15) * 1024 + 8 * g, WOT + (size_t)(colw + 16 + l15) * 1024 + 8 * g, 1024, acc);
    const float* xr = p.x_s + (size_t)(tok - NTP) * 1024;
#pragma unroll
    for (int tt = 0; tt < 2; ++tt) {
        const int col = colw + 16 * tt + 4 * g;
        const f32x4 xv = *(const f32x4*)(xr + col);
        *(f32x4*)(p.out + (size_t)tok * 1024 + col) = xv + acc[tt];
    }
}

DEVI unsigned ordkey(float x) { const unsigned u = __float_as_uint(x); return (u & 0x80000000u) ? ~u : (u | 0x80000000u); }

constexpr int TK_QS = 16 * 1040, TK_ROW = 2052;

DEVI unsigned long long cmp_ge_mask(unsigned k, unsigned mid) { unsigned long long m; asm("v_cmp_ge_u32_e64 %0, %1, %2" : "=s"(m) : "v"(k), "s"(mid)); return m; }
DEVI int count_ge8(const unsigned* k, unsigned mid) {
    unsigned long long m0, m1, m2, m3, m4, m5, m6, m7;
    int c, t1, t2, t3;
    asm("v_cmp_ge_u32_e64 %0, %12, %20\n\t"
        "v_cmp_ge_u32_e64 %1, %13, %20\n\t"
        "v_cmp_ge_u32_e64 %2, %14, %20\n\t"
        "v_cmp_ge_u32_e64 %3, %15, %20\n\t"
        "v_cmp_ge_u32_e64 %4, %16, %20\n\t"
        "v_cmp_ge_u32_e64 %5, %17, %20\n\t"
        "v_cmp_ge_u32_e64 %6, %18, %20\n\t"
        "v_cmp_ge_u32_e64 %7, %19, %20\n\t"
        "s_bcnt1_i32_b64 %8, %0\n\t"
        "s_bcnt1_i32_b64 %9, %1\n\t"
        "s_bcnt1_i32_b64 %10, %2\n\t"
        "s_bcnt1_i32_b64 %11, %3\n\t"
        "s_add_i32 %8, %8, %9\n\t"
        "s_add_i32 %10, %10, %11\n\t"
        "s_bcnt1_i32_b64 %9, %4\n\t"
        "s_bcnt1_i32_b64 %11, %5\n\t"
        "s_add_i32 %8, %8, %10\n\t"
        "s_add_i32 %9, %9, %11\n\t"
        "s_bcnt1_i32_b64 %10, %6\n\t"
        "s_bcnt1_i32_b64 %11, %7\n\t"
        "s_add_i32 %8, %8, %9\n\t"
        "s_add_i32 %10, %10, %11\n\t"
        "s_add_i32 %8, %8, %10"
        : "=&s"(m0), "=&s"(m1), "=&s"(m2), "=&s"(m3), "=&s"(m4), "=&s"(m5), "=&s"(m6), "=&s"(m7), "=&s"(c), "=&s"(t1), "=&s"(t2), "=&s"(t3)
        : "v"(k[0]), "v"(k[1]), "v"(k[2]), "v"(k[3]), "v"(k[4]), "v"(k[5]), "v"(k[6]), "v"(k[7]), "s"(mid)
        : "scc");
    return c;
}

DEVI unsigned wave_umax(unsigned v) {
    unsigned t;
    t = (unsigned)__builtin_amdgcn_update_dpp(0, (int)v, 0xB1, 0xF, 0xF, true); v = v > t ? v : t;
    t = (unsigned)__builtin_amdgcn_update_dpp(0, (int)v, 0x4E, 0xF, 0xF, true); v = v > t ? v : t;
    t = (unsigned)__builtin_amdgcn_update_dpp(0, (int)v, 0x141, 0xF, 0xF, true); v = v > t ? v : t;
    t = (unsigned)__builtin_amdgcn_update_dpp(0, (int)v, 0x140, 0xF, 0xF, true); v = v > t ? v : t;
    const unsigned a = (unsigned)__builtin_amdgcn_readlane((int)v, 0), b = (unsigned)__builtin_amdgcn_readlane((int)v, 16);
    const unsigned c = (unsigned)__builtin_amdgcn_readlane((int)v, 32), d = (unsigned)__builtin_amdgcn_readlane((int)v, 48);
    const unsigned ab = a > b ? a : b, cd = c > d ? c : d;
    return ab > cd ? ab : cd;
}
DEVI unsigned lowbits32(unsigned m, int t) {
    int p = 0;
#pragma unroll
    for (int k = 16; k >= 1; k >>= 1) { if (__builtin_popcount(m & ((1u << (p + k)) - 1u)) < t) p += k; }
    const unsigned keep = (p == 31) ? 0xFFFFFFFFu : ((2u << p) - 1u);
    return (t <= 0) ? 0u : (m & keep);
}
DEVI void topk_select2(const unsigned (&kA)[64], const unsigned (&kB)[64], const bool two, const int lim, bf16_t* mrowA, bf16_t* mrowB, const int lane) {
    unsigned loA = 0u, hiA = 0xFFFFFFFFu, TA = 1u, loB = 0u, hiB = 0xFFFFFFFFu, TB = 1u;
    int clA = lim, chA = 0, needA = 0, clB = lim, chB = 0, needB = 0;
    bool dA = (lim <= 256), dB = dA;
    int itn = 0;
    unsigned sdA = 0xBC800000u, sdB = 0xBC800000u;
    if (!dA) {
        unsigned mA = 0u, mB = 0u;
#pragma unroll
        for (int j = 0; j < 64; ++j) if (j < 32 || two) { mA = mA > kA[j] ? mA : kA[j]; mB = mB > kB[j] ? mB : kB[j]; }
        mA = wave_umax(mA); mB = wave_umax(mB);
        hiA = mA + 1u; hiB = mB + 1u;
        if (mA > 0x80000000u + (8u << 23)) sdA = mA - (3u << 23);
        if (mB > 0x80000000u + (8u << 23)) sdB = mB - (3u << 23);
    }
    while (!(dA && dB)) {
        unsigned pa = loA + ((hiA - loA) >> 1), pb = loB + ((hiB - loB) >> 1);
        if (itn == 0) { if (sdA > loA && sdA < hiA) pa = sdA; if (sdB > loB && sdB < hiB) pb = sdB; }
        else if (itn == 1) {
            if (0xC1000000u > loA && 0xC1000000u < hiA) pa = 0xC1000000u; else if (loA == 0u && 0xBC800000u < hiA) pa = 0xBC800000u;
            if (0xC1000000u > loB && 0xC1000000u < hiB) pb = 0xC1000000u; else if (loB == 0u && 0xBC800000u < hiB) pb = 0xBC800000u;
        }
        ++itn;
        const unsigned midA = __builtin_amdgcn_readfirstlane(pa), midB = __builtin_amdgcn_readfirstlane(pb);
        int cA = 0, cB = 0;
        if (!dA) {
            cA = count_ge8(&kA[0], midA) + count_ge8(&kA[8], midA) + count_ge8(&kA[16], midA) + count_ge8(&kA[24], midA);
            if (two) cA += count_ge8(&kA[32], midA) + count_ge8(&kA[40], midA) + count_ge8(&kA[48], midA) + count_ge8(&kA[56], midA);
        }
        if (!dB) {
            cB = count_ge8(&kB[0], midB) + count_ge8(&kB[8], midB) + count_ge8(&kB[16], midB) + count_ge8(&kB[24], midB);
            if (two) cB += count_ge8(&kB[32], midB) + count_ge8(&kB[40], midB) + count_ge8(&kB[48], midB) + count_ge8(&kB[56], midB);
        }
        if (!dA) {
            if (cA >= 256) { loA = midA; clA = cA; } else { hiA = midA; chA = cA; }
            if (cA == 256) { TA = midA; needA = 0; dA = true; }
            else if (hiA - loA == 1u) { TA = loA; needA = (clA == 256) ? 0 : (256 - chA); dA = true; }
        }
        if (!dB) {
            if (cB >= 256) { loB = midB; clB = cB; } else { hiB = midB; chB = cB; }
            if (cB == 256) { TB = midB; needB = 0; dB = true; }
            else if (hiB - loB == 1u) { TB = loB; needB = (clB == 256) ? 0 : (256 - chB); dB = true; }
        }
    }
    unsigned geAl = 0, geAh = 0, geBl = 0, geBh = 0;
#pragma unroll
    for (int j = 0; j < 64; ++j) {
        if (j < 32 || two) {
            const unsigned long long a = cmp_ge_mask(kA[j], TA), bq = cmp_ge_mask(kB[j], TB);
            const bool me = (lane == j);
            geAl = me ? (unsigned)a : geAl; geAh = me ? (unsigned)(a >> 32) : geAh;
            geBl = me ? (unsigned)bq : geBl; geBh = me ? (unsigned)(bq >> 32) : geBh;
        }
    }
    if (needA > 0) {
        unsigned gtAl = 0, gtAh = 0;
        const unsigned TA1 = TA + 1u;
#pragma unroll
        for (int j = 0; j < 64; ++j) {
            if (j < 32 || two) { const unsigned long long a2 = cmp_ge_mask(kA[j], TA1); const bool me = (lane == j); gtAl = me ? (unsigned)a2 : gtAl; gtAh = me ? (unsigned)(a2 >> 32) : gtAh; }
        }
        unsigned el = geAl & ~gtAl, eh = geAh & ~gtAh;
        const int pc = __builtin_popcount(el) + __builtin_popcount(eh);
        int pre = pc;
#pragma unroll
        for (int d = 1; d < 64; d <<= 1) { const int t = __shfl_up(pre, d); if (lane >= d) pre += t; }
        int take = needA - (pre - pc); take = take < 0 ? 0 : (take > pc ? pc : take);
        const int pl = __builtin_popcount(el); const int tl = take < pl ? take : pl;
        el = lowbits32(el, tl); eh = lowbits32(eh, take - tl);
        geAl = gtAl | el; geAh = gtAh | eh;
    }
    if (needB > 0) {
        unsigned gtBl = 0, gtBh = 0;
        const unsigned TB1 = TB + 1u;
#pragma unroll
        for (int j = 0; j < 64; ++j) {
            if (j < 32 || two) { const unsigned long long b2 = cmp_ge_mask(kB[j], TB1); const bool me = (lane == j); gtBl = me ? (unsigned)b2 : gtBl; gtBh = me ? (unsigned)(b2 >> 32) : gtBh; }
        }
        unsigned el = geBl & ~gtBl, eh = geBh & ~gtBh;
        const int pc = __builtin_popcount(el) + __builtin_popcount(eh);
        int pre = pc;
#pragma unroll
        for (int d = 1; d < 64; d <<= 1) { const int t = __shfl_up(pre, d); if (lane >= d) pre += t; }
        int take = needB - (pre - pc); take = take < 0 ? 0 : (take > pc ? pc : take);
        const int pl = __builtin_popcount(el); const int tl = take < pl ? take : pl;
        el = lowbits32(el, tl); eh = lowbits32(eh, take - tl);
        geBl = gtBl | el; geBh = gtBh | eh;
    }
    u32x2 o; o.x = geAl; o.y = geAh; *(u32x2*)(mrowA + 4 * lane) = o;
    o.x = geBl; o.y = geBh; *(u32x2*)(mrowB + 4 * lane) = o;
}

DEVI void topk_unit(const Params& p, const int u, unsigned char* smem) {
    int tid = threadIdx.x; asm volatile("" : "+v"(tid));
    const int lane = tid & 63, w = tid >> 6, l15 = lane & 15, g = lane >> 4;
    int wq = w * 16 + 4 * g; asm volatile("" : "+v"(wq));
    int wl = w * 16 + l15; asm volatile("" : "+v"(wl));
    unsigned char* qs = smem;
    unsigned* KL = (unsigned*)(smem + TK_QS);
    const bool prompt = u < 2048;
    int b, tok0, lim;
    if (prompt) { b = u & 7; const int qt = u >> 3; tok0 = b * 4096 + qt * 16; lim = (((qt * 16) >> 6) + 1) * 64; }
    else { const int v = u - 2048; b = v >> 1; tok0 = NTP + b * 32 + (v & 1) * 16; lim = 2080; }
    const int ni = (lim + 127) >> 7;
    const int npair = (ni + 1) >> 1;
    const bf16_t* QI = (const bf16_t*)(p.ws + W_QI);
#pragma unroll
    for (int j = 0; j < 2; ++j) {
        const int id = tid + 512 * j, row = id >> 6, c = id & 63;
        *(u32x4*)(qs + row * 1040 + c * 16) = *(const u32x4*)(QI + (size_t)(tok0 + row) * 512 + c * 8);
    }
    float wv[8];
    {
        const float* WI = (const float*)(p.ws + W_WI) + (size_t)(tok0 + l15) * 8;
        const f32x4 a = *(const f32x4*)WI, c = *(const f32x4*)(WI + 4);
        wv[0] = a[0] * 0.125f; wv[1] = a[1] * 0.125f; wv[2] = a[2] * 0.125f; wv[3] = a[3] * 0.125f;
        wv[4] = c[0] * 0.125f; wv[5] = c[1] * 0.125f; wv[6] = c[2] * 0.125f; wv[7] = c[3] * 0.125f;
    }
    const bf16_t* KIP = (const bf16_t*)(p.ws + W_KIP) + (size_t)b * 4096 * 64 + 8 * g;
    const float* CIK = p.c_ik + (size_t)b * 2048 * 64 + 8 * g;
    const float* NIK = p.out + O_IKS + (size_t)b * 32 * 64 + 8 * g;
#define TK_LOADK(dst0, dst1, i_) do { \
        const int s_ = wl + 128 * (i_); \
        if (prompt) { const bf16_t* kp_ = KIP + (size_t)s_ * 64; dst0 = *(const u32x4*)kp_; dst1 = *(const u32x4*)(kp_ + 32); } \
        else { const int sc_ = s_ < 2079 ? s_ : 2079; const float* kp_ = (sc_ < 2048) ? CIK + (size_t)sc_ * 64 : NIK + (size_t)(sc_ - 2048) * 64; \
            const f32x4 a0_ = *(const f32x4*)kp_, a1_ = *(const f32x4*)(kp_ + 4), a2_ = *(const f32x4*)(kp_ + 32), a3_ = *(const f32x4*)(kp_ + 36); \
            dst0.x = pk_bf16(a0_[0], a0_[1]); dst0.y = pk_bf16(a0_[2], a0_[3]); dst0.z = pk_bf16(a1_[0], a1_[1]); dst0.w = pk_bf16(a1_[2], a1_[3]); \
            dst1.x = pk_bf16(a2_[0], a2_[1]); dst1.y = pk_bf16(a2_[2], a2_[3]); dst1.z = pk_bf16(a3_[0], a3_[1]); dst1.w = pk_bf16(a3_[2], a3_[3]); } } while (0)
    u32x4 ka0, ka1, kb0, kb1, na0, na1, nb0, nb1;
    TK_LOADK(ka0, ka1, 0); TK_LOADK(kb0, kb1, 1);
    na0 = ka0; na1 = ka1; nb0 = kb0; nb1 = kb1;
    __syncthreads();
    unsigned keyA[64], keyB[64];
#pragma unroll
    for (int c = 0; c < 2; ++c) {
        if (8 * c < npair) {
            const int ipe = (npair < 8 * c + 8) ? npair : (8 * c + 8);
#pragma unroll 1
            for (int ip = 8 * c; ip < ipe; ++ip) {
                if (ip + 1 < npair) { TK_LOADK(na0, na1, 2 * ip + 2); TK_LOADK(nb0, nb1, 2 * ip + 3); }
                f32x4 sa = (f32x4){0.f, 0.f, 0.f, 0.f}, sb4 = (f32x4){0.f, 0.f, 0.f, 0.f};
#pragma unroll
                for (int h = 0; h < 8; ++h) {
                    const bf16x8 q0 = *(const bf16x8*)(qs + l15 * 1040 + (h * 64 + 8 * g) * 2);
                    const bf16x8 q1 = *(const bf16x8*)(qs + l15 * 1040 + (h * 64 + 32 + 8 * g) * 2);
                    f32x4 da = mfma16(__builtin_bit_cast(bf16x8, ka0), q0, (f32x4){0.f, 0.f, 0.f, 0.f});
                    f32x4 db = mfma16(__builtin_bit_cast(bf16x8, kb0), q0, (f32x4){0.f, 0.f, 0.f, 0.f});
                    da = mfma16(__builtin_bit_cast(bf16x8, ka1), q1, da);
                    db = mfma16(__builtin_bit_cast(bf16x8, kb1), q1, db);
#pragma unroll
                    for (int r = 0; r < 4; ++r) { sa[r] = fmaf(relu_(da[r]), wv[h], sa[r]); sb4[r] = fmaf(relu_(db[r]), wv[h], sb4[r]); }
                }
                u32x4 oa, ob;
                const int sk = wq + 256 * ip;
                oa.x = (sk + 0 < lim) ? ordkey(sa[0] + 0.0f) : 0u; oa.y = (sk + 1 < lim) ? ordkey(sa[1] + 0.0f) : 0u;
                oa.z = (sk + 2 < lim) ? ordkey(sa[2] + 0.0f) : 0u; oa.w = (sk + 3 < lim) ? ordkey(sa[3] + 0.0f) : 0u;
                ob.x = (sk + 128 < lim) ? ordkey(sb4[0] + 0.0f) : 0u; ob.y = (sk + 129 < lim) ? ordkey(sb4[1] + 0.0f) : 0u;
                ob.z = (sk + 130 < lim) ? ordkey(sb4[2] + 0.0f) : 0u; ob.w = (sk + 131 < lim) ? ordkey(sb4[3] + 0.0f) : 0u;
                unsigned* kw = KL + l15 * TK_ROW + (wq + 256 * (ip - 8 * c));
                *(u32x4*)kw = oa; *(u32x4*)(kw + 128) = ob;
                ka0 = na0; ka1 = na1; kb0 = nb0; kb1 = nb1;
            }
            __syncthreads();
            const unsigned* ra = KL + (2 * w) * TK_ROW + lane; const unsigned* rb = ra + TK_ROW;
#pragma unroll
            for (int jg = 0; jg < 8; ++jg) {
                if (8 * c + jg < npair) {
#pragma unroll
                    for (int jj = 0; jj < 4; ++jj) { const int j = 4 * jg + jj; keyA[32 * c + j] = ra[64 * j]; keyB[32 * c + j] = rb[64 * j]; }
                } else {
#pragma unroll
                    for (int jj = 0; jj < 4; ++jj) { const int j = 4 * jg + jj; keyA[32 * c + j] = 0u; keyB[32 * c + j] = 0u; }
                }
            }
            __syncthreads();
        } else {
#pragma unroll
            for (int j = 0; j < 32; ++j) { keyA[32 * c + j] = 0u; keyB[32 * c + j] = 0u; }
        }
    }
#undef TK_LOADK
    bf16_t* MK = (bf16_t*)(p.ws + W_MASK);
    topk_select2(keyA, keyB, npair > 8, lim, MK + (size_t)(tok0 + 2 * w) * 256, MK + (size_t)(tok0 + 2 * w + 1) * 256, lane);
}

constexpr int ATT_K = 64 * 144, ATT_V = 64 * 136, ATT_BUF = ATT_K + ATT_V;

template <int MODE, bool SAMPLE>
DEVI void attn_unit(const Params& p, const int b, const int h, const int qt, unsigned char* smem) {
    int tid = threadIdx.x; asm volatile("" : "+v"(tid));
    const int lane = tid & 63, w = tid >> 6, l15 = lane & 15, g = lane >> 4;
    const int tok0 = SAMPLE ? (NTP + b * 32) : (b * 4096 + qt * 256 + 32 * w);
    const int pos0 = SAMPLE ? 2048 : (qt * 256 + 32 * w);
    const bool active = SAMPLE ? (w == 0) : true;
    const int nkt = SAMPLE ? 33 : 4 * (qt + 1);
    const int kt_hi = nkt - 1;
    const bf16_t* Kb = nullptr; const bf16_t* Vb = nullptr; const float* Kc = nullptr; const float* Vc = nullptr; const float* Kn = nullptr; const float* Vn = nullptr;
    if (!SAMPLE) {
        Kb = (const bf16_t*)(p.ws + (MODE == 0 ? W_KAP : W_KBP)) + (size_t)b * 4096 * 512 + h * 64;
        Vb = (const bf16_t*)(p.ws + (MODE == 0 ? W_VAP : W_VBP)) + (size_t)b * 4096 * 512 + h * 64;
    } else {
        Kc = (MODE == 0 ? p.ca_k : p.cb_k) + (size_t)b * 2048 * 512 + h * 64;
        Vc = (MODE == 0 ? p.ca_v : p.cb_v) + (size_t)b * 2048 * 512 + h * 64;
        Kn = p.out + (MODE == 0 ? O_AKS : O_BKS) + (size_t)b * 32 * 512 + h * 64;
        Vn = p.out + (MODE == 0 ? O_AVS : O_BVS) + (size_t)b * 32 * 512 + h * 64;
    }
    const bf16_t* Q = (const bf16_t*)(p.ws + (MODE == 0 ? W_QA : W_QB));
    bf16x8 qf[2][2];
#pragma unroll
    for (int j = 0; j < 2; ++j)
#pragma unroll
        for (int kh = 0; kh < 2; ++kh) qf[j][kh] = *(const bf16x8*)(Q + (size_t)(tok0 + 16 * j + l15) * 512 + h * 64 + 32 * kh + 8 * g);
    f32x4 O[4][2];
#pragma unroll
    for (int dt = 0; dt < 4; ++dt)
#pragma unroll
        for (int j = 0; j < 2; ++j) O[dt][j] = (f32x4){0.f, 0.f, 0.f, 0.f};
    float st_m[2] = {-1e29f, -1e29f};
    float st_l[2] = {MODE == 0 ? 0.f : 1.f, MODE == 0 ? 0.f : 1.f};
    const bf16_t* MK = (const bf16_t*)(p.ws + W_MASK);
    const int limw = SAMPLE ? 2112 : (qt * 256 + 64 * ((w >> 1) + 1));

    u32x4 kr[2], vr[2];
    auto gload = [&](const int kt) {
        if (!SAMPLE) {
            const int s = 64 * kt + (tid >> 3), c = tid & 7;
            kr[0] = *(const u32x4*)(Kb + (size_t)s * 512 + 8 * c);
            if (tid < 256) {
                const int pr = tid >> 3;
                vr[0] = *(const u32x4*)(Vb + (size_t)(64 * kt + 2 * pr) * 512 + 8 * c);
                vr[1] = *(const u32x4*)(Vb + (size_t)(64 * kt + 2 * pr + 1) * 512 + 8 * c);
            }
        } else {
            {
                const int s = 64 * kt + (tid >> 3), c = tid & 7;
                const bool ok = s < 2080;
                const int sc = ok ? s : 2079;
                const float* rp = (sc < 2048) ? Kc + (size_t)sc * 512 : Kn + (size_t)(sc - 2048) * 512;
                f32x4 a0 = *(const f32x4*)(rp + 8 * c), a1 = *(const f32x4*)(rp + 8 * c + 4);
                if (!ok) { a0 = (f32x4){0.f, 0.f, 0.f, 0.f}; a1 = a0; }
                kr[0].x = pk_bf16(a0[0], a0[1]); kr[0].y = pk_bf16(a0[2], a0[3]); kr[0].z = pk_bf16(a1[0], a1[1]); kr[0].w = pk_bf16(a1[2], a1[3]);
            }
            {
                const int pr = tid >> 4, c4 = tid & 15;
                const int s = 64 * kt + 2 * pr;
                const bool ok = s < 2080;
                const int sc = ok ? s : 2078;
                const float* rp = (sc < 2048) ? Vc + (size_t)sc * 512 : Vn + (size_t)(sc - 2048) * 512;
                f32x4 a0 = *(const f32x4*)(rp + 4 * c4), a1 = *(const f32x4*)(rp + 512 + 4 * c4);
                if (!ok) { a0 = (f32x4){0.f, 0.f, 0.f, 0.f}; a1 = a0; }
                vr[0].x = pk_bf16(a0[0], a1[0]); vr[0].y = pk_bf16(a0[1], a1[1]); vr[0].z = pk_bf16(a0[2], a1[2]); vr[0].w = pk_bf16(a0[3], a1[3]);
            }
        }
    };
    auto lstore = [&](const int bufi) {
        unsigned char* Ks = smem + bufi * ATT_BUF; unsigned char* Vs = Ks + ATT_K;
        {
            const int s = tid >> 3, c = tid & 7;
            *(u32x4*)(Ks + s * 144 + c * 16) = kr[0];
        }
        if (!SAMPLE) {
            if (tid < 256) {
                const int pr = tid >> 3, c = tid & 7;
                const unsigned a[4] = {vr[0].x, vr[0].y, vr[0].z, vr[0].w}, bb[4] = {vr[1].x, vr[1].y, vr[1].z, vr[1].w};
#pragma unroll
                for (int i = 0; i < 4; ++i) {
                    const unsigned lo = (a[i] & 0xffffu) | (bb[i] << 16);
                    const unsigned hi2 = (a[i] >> 16) | (bb[i] & 0xffff0000u);
                    *(unsigned*)(Vs + (8 * c + 2 * i) * 136 + pr * 4) = lo;
                    *(unsigned*)(Vs + (8 * c + 2 * i + 1) * 136 + pr * 4) = hi2;
                }
            }
        } else {
            const int pr = tid >> 4, c4 = tid & 15;
            *(unsigned*)(Vs + (4 * c4 + 0) * 136 + pr * 4) = vr[0].x;
            *(unsigned*)(Vs + (4 * c4 + 1) * 136 + pr * 4) = vr[0].y;
            *(unsigned*)(Vs + (4 * c4 + 2) * 136 + pr * 4) = vr[0].z;
            *(unsigned*)(Vs + (4 * c4 + 3) * 136 + pr * 4) = vr[0].w;
        }
    };

    u32x2 mw[2] = {(u32x2){0u, 0u}, (u32x2){0u, 0u}}, mwn[2] = {(u32x2){0u, 0u}, (u32x2){0u, 0u}};
    if (MODE == 0 && active) {
#pragma unroll
        for (int j = 0; j < 2; ++j) mw[j] = *(const u32x2*)(MK + (size_t)(tok0 + 16 * j + l15) * 256);
    }
    gload(MODE == 0 ? 0 : kt_hi);
    lstore(0);
    __syncthreads();
    for (int it = 0; it < nkt; ++it) {
        const int kt = (MODE == 0) ? it : (kt_hi - it);
        if (it + 1 < nkt) gload((MODE == 0) ? (it + 1) : (kt_hi - it - 1));
        const unsigned char* Ks = smem + (it & 1) * ATT_BUF; const unsigned char* Vs = Ks + ATT_K;
        bool work = active;
        if (MODE == 0) work = work && (64 * kt < limw);
        else work = work && (64 * kt < pos0 + 31);
        if (MODE == 0) {
            if (active && it + 1 < nkt && 64 * (it + 1) < limw) {
#pragma unroll
                for (int j = 0; j < 2; ++j) mwn[j] = *(const u32x2*)(MK + (size_t)(tok0 + 16 * j + l15) * 256 + 4 * (it + 1));
            }
        }
        if (work) {
            f32x4 S[4][2];
#pragma unroll
            for (int st = 0; st < 4; ++st) {
                const bf16x8 k0 = *(const bf16x8*)(Ks + (16 * st + l15) * 144 + (8 * g) * 2);
                const bf16x8 k1 = *(const bf16x8*)(Ks + (16 * st + l15) * 144 + (32 + 8 * g) * 2);
#pragma unroll
                for (int j = 0; j < 2; ++j) {
                    f32x4 d = mfma16(k0, qf[j][0], (f32x4){0.f, 0.f, 0.f, 0.f});
                    S[st][j] = mfma16(k1, qf[j][1], d);
                }
            }
            u32x4 pf[2][2];
            if (MODE == 0) {
                float mnew[2], alpha[2];
#pragma unroll
                for (int j = 0; j < 2; ++j) {
                    float mx = -1e30f;
#pragma unroll
                    for (int st = 0; st < 4; ++st) {
                        const unsigned word = (st < 2) ? mw[j].x : mw[j].y;
                        const unsigned nib = word >> (16 * (st & 1) + 4 * g);
#pragma unroll
                        for (int r = 0; r < 4; ++r) {
                            const int sel = __builtin_amdgcn_sbfe(nib, r, 1);
                            const unsigned bits = (__float_as_uint(S[st][j][r]) & (unsigned)sel) | (0xF149F2CAu & ~(unsigned)sel);
                            S[st][j][r] = __uint_as_float(bits);
                        }
                        mx = fmaxf(mx, fmaxf(fmaxf(S[st][j][0], S[st][j][1]), fmaxf(S[st][j][2], S[st][j][3])));
                    }
                    mx = fmaxf(mx, shx(mx, 16)); mx = fmaxf(mx, shx(mx, 32));
                    mnew[j] = (mx > st_m[j] + 8.0f) ? mx : st_m[j];
                    alpha[j] = __builtin_amdgcn_exp2f(st_m[j] - mnew[j]);
                }
#pragma unroll
                for (int j = 0; j < 2; ++j) {
                    float ps = 0.f;
#pragma unroll
                    for (int st = 0; st < 4; ++st)
#pragma unroll
                        for (int r = 0; r < 4; ++r) { const float pv = __builtin_amdgcn_exp2f(S[st][j][r] - mnew[j]);   S[st][j][r] = pv; ps += pv; }
                    st_l[j] = st_l[j] * alpha[j] + ps;
                    st_m[j] = mnew[j];
                }
                if (!__all(alpha[0] == 1.0f && alpha[1] == 1.0f)) {
#pragma unroll
                    for (int j = 0; j < 2; ++j)
#pragma unroll
                        for (int dt = 0; dt < 4; ++dt) O[dt][j] = O[dt][j] * alpha[j];
                }
            } else {
#pragma unroll
                for (int j = 0; j < 2; ++j) {
                    const int t = pos0 + 16 * j + l15;
                    float P = st_l[j];
#pragma unroll
                    for (int st = 3; st >= 0; --st) {
                        const int sb = 64 * kt + 16 * st + 4 * g;
                        float sg[4], om[4];
#pragma unroll
                        for (int r = 0; r < 4; ++r) {
                            const int sbits = __float_as_int(S[st][j][r]);
                            const float uu = __builtin_amdgcn_exp2f(__int_as_float(sbits < 0x42e6d4ca ? sbits : 0x42e6d4ca));
                            const float sgm = __builtin_amdgcn_rcpf(1.0f + uu);
                            const bool valid = (sb + r) < t;
                            sg[r] = valid ? sgm : 0.f;
                            om[r] = valid ? (uu * sgm) : 1.f;
                        }
                        const float x2 = om[3], x1 = x2 * om[2], x0 = x1 * om[1], tot = x0 * om[0];
                        const float a_ = shx(tot, 16);
                        const float pair = tot * a_;
                        const float b_ = shx(pair, 32);
                        const float cross = (g == 0) ? (a_ * b_) : (g == 1) ? b_ : (g == 2) ? a_ : 1.f;
                        const float base = P * cross;
                        S[st][j][0] = sg[0] * (base * x0); S[st][j][1] = sg[1] * (base * x1); S[st][j][2] = sg[2] * (base * x2); S[st][j][3] = sg[3] * base;
                        P *= pair * b_;
                    }
                    st_l[j] = P;
                }
            }
#pragma unroll
            for (int j = 0; j < 2; ++j)
#pragma unroll
                for (int ks = 0; ks < 2; ++ks) {
                    pf[j][ks].x = pk_bf16(S[2 * ks][j][0], S[2 * ks][j][1]); pf[j][ks].y = pk_bf16(S[2 * ks][j][2], S[2 * ks][j][3]);
                    pf[j][ks].z = pk_bf16(S[2 * ks + 1][j][0], S[2 * ks + 1][j][1]); pf[j][ks].w = pk_bf16(S[2 * ks + 1][j][2], S[2 * ks + 1][j][3]);
                }
#pragma unroll
            for (int dt = 0; dt < 4; ++dt)
#pragma unroll
                for (int ks = 0; ks < 2; ++ks) {
                    const u32x2 v0 = *(const u32x2*)(Vs + (16 * dt + l15) * 136 + (32 * ks + 4 * g) * 2);
                    const u32x2 v1 = *(const u32x2*)(Vs + (16 * dt + l15) * 136 + (32 * ks + 16 + 4 * g) * 2);
                    const u32x4 vv = (u32x4){v0.x, v0.y, v1.x, v1.y};
                    const bf16x8 vf = __builtin_bit_cast(bf16x8, vv);
#pragma unroll
                    for (int j = 0; j < 2; ++j) O[dt][j] = mfma16(vf, __builtin_bit_cast(bf16x8, pf[j][ks]), O[dt][j]);
                }
        }
        if (it + 1 < nkt) lstore((it + 1) & 1);
        if (MODE == 0) { mw[0] = mwn[0]; mw[1] = mwn[1]; }
        if (MODE == 1) {
            const int wdone = (!active) || __all((st_l[0] == 0.f) && (st_l[1] == 0.f));
            volatile int* flags = (volatile int*)(smem + 2 * ATT_BUF) + (it & 1) * 8;
            if (lane == 0) flags[w] = wdone;
            __syncthreads();
            const int alld = flags[0] & flags[1] & flags[2] & flags[3] & flags[4] & flags[5] & flags[6] & flags[7];
            if (alld) break;
        } else {
            __syncthreads();
        }
    }
    if (active) {
        const bf16_t* SU = (const bf16_t*)(p.ws + (MODE == 0 ? W_SUA : W_SUB));
        bf16_t* OAB = (bf16_t*)(p.ws + W_OAB);
#pragma unroll
        for (int j = 0; j < 2; ++j) {
            float inv = 1.0f;
            if (MODE == 0) { float l = st_l[j]; l += shx(l, 16); l += shx(l, 32); inv = (l > 0.f) ? __builtin_amdgcn_rcpf(l) : 0.f; }
            const int tok = tok0 + 16 * j + l15;
#pragma unroll
            for (int dt = 0; dt < 4; ++dt) {
                const int col = h * 64 + 16 * dt + 4 * g;
                const u32x2 su = *(const u32x2*)(SU + (size_t)tok * 512 + col);
                f32x4 o = O[dt][j] * inv;
                u32x2 ov; ov.x = pk_bf16(o[0] * bf_lo(su.x), o[1] * bf_hi(su.x)); ov.y = pk_bf16(o[2] * bf_lo(su.y), o[3] * bf_hi(su.y));
                *(u32x2*)(OAB + (MODE == 0 ? (size_t)0 : (size_t)NTOK * 512) + (size_t)tok * 512 + col) = ov;
            }
        }
    }
    __syncthreads();
}

template <int PH>
DEVI void run_phase(const Params& p, unsigned char* smem) {
    const int nb = gridDim.x, bid = blockIdx.x;
    PG8_LAS unsigned char* lds = (PG8_LAS unsigned char*)smem;
    if (PH == 0) {
        phase0(p, smem);
    } else if (PH == 1) {
        EpiProj epi; epi.pp = &p;
        pg8::Gemm g{(const bf16_t*)(p.ws + W_XN), (const bf16_t*)(p.ws + W_WINT), nullptr, nullptr, 1024};
        OrderP1 S; S.init();
        pg8::gemm_phase(lds, g, S, epi);
    } else if (PH == 2) {
        for (int u = bid; u < 2112; u += nb) topk_unit(p, u, smem);
        if (nb == 256) {
            if (bid < 64) { for (int v = 2 * bid; v < 2 * bid + 2; ++v) attn_unit<1, false>(p, v >> 7, (v >> 4) & 7, 15 - (v & 15), smem); }
            else { for (int v = 128 + (bid - 64); v < 1024; v += 192) attn_unit<1, false>(p, v >> 7, (v >> 4) & 7, 15 - (v & 15), smem); }
        } else {
            for (int v = bid; v < 1024; v += nb) attn_unit<1, false>(p, v >> 7, (v >> 4) & 7, 15 - (v & 15), smem);
        }
        for (int v = bid; v < 256; v += nb) attn_unit<1, true>(p, v >> 3, v & 7, 0, smem);
    } else if (PH == 3) {
        for (int su0 = bid; su0 < 256; su0 += nb) {
            const int su = (nb == 256) ? (((su0 & 7) << 5) | (su0 >> 3)) : su0;
            const int b = su >> 5, h = (su >> 2) & 7, x = su & 3;
            for (int k = 0; k < 4; ++k) {
                const int qt = (k == 0) ? 15 - x : (k == 1) ? 8 + x : (k == 2) ? 7 - x : x;
                attn_unit<0, false>(p, b, h, qt, smem);
            }
            attn_unit<0, true>(p, su >> 3, su & 7, 0, smem);
        }
    } else if (PH == 4) {
        for (int t = bid; t < 256; t += nb) mini_mix_tile(p, t);
        EpiMix epi; epi.pp = &p;
        const bf16_t* OA = (const bf16_t*)(p.ws + W_OAB); const bf16_t* WAT = (const bf16_t*)(p.ws + W_WABT);
        pg8::Gemm g{OA, WAT, OA + (size_t)NTOK * 512, WAT + 1024 * 512, 512};
        OrderP4 S; S.init(true);
        pg8::gemm_phase(lds, g, S, epi);
    } else if (PH == 5) {
        for (int t = bid; t < 256; t += nb) mini_y_tile(p, t);
        EpiY epi; epi.pp = &p;
        pg8::Gemm g{(const bf16_t*)(p.ws + W_XN), (const bf16_t*)(p.ws + W_WOT), nullptr, nullptr, 1024};
        OrderP4 S; S.init(false);
        pg8::gemm_phase(lds, g, S, epi);
    }
}

#define XB_TMO      128
#define XB_XCNT(j)  (256  + 64 * (j))
#define XB_XSUB(j)  (1280 + 64 * (j))
#define XB_XGEN(j)  (2304 + 64 * (j))
#define XB_TOP      3328
#define XB_TOPGEN   3392
#define XB_SPIN_CAP (1u << 18)
DEVI unsigned xb_ld(unsigned* p)              { return __hip_atomic_load(p, __ATOMIC_RELAXED, __HIP_MEMORY_SCOPE_AGENT); }
DEVI unsigned xb_add(unsigned* p, unsigned v) { return __hip_atomic_fetch_add(p, v, __ATOMIC_RELAXED, __HIP_MEMORY_SCOPE_AGENT); }
DEVI unsigned xb_xcc_id() { return (unsigned)__builtin_amdgcn_s_getreg((3 << 11) | 20) & 0xFu; }
#define XB_SPIN(cond, bar) do { unsigned _sp = 0; while (cond) { __builtin_amdgcn_s_sleep(1); \
    if ((++_sp & 255u) == 0u) { if (xb_ld(&(bar)[XB_TMO])) break; if (_sp > XB_SPIN_CAP) { atomicAdd(&(bar)[XB_TMO], 1u); break; } } } } while (0)
struct XcdBarrier { unsigned* bar; unsigned x; volatile PG8_LAS unsigned* st; };
DEVI XcdBarrier xcd_barrier_post(unsigned* bar, volatile PG8_LAS unsigned* st) {
    XcdBarrier b; b.bar = bar; b.x = xb_xcc_id(); b.st = st;
    if (threadIdx.x == 0) (void)xb_add(&bar[XB_XCNT(b.x)], 1u);
    return b;
}
DEVI void xcd_barrier_complete(unsigned* bar, unsigned x, unsigned& nloc, unsigned& nx) {
    const unsigned G = gridDim.x * gridDim.y * gridDim.z;
    unsigned sum, cnt, mine, sp = 0u;
    for (;;) {
        sum = 0u; cnt = 0u; mine = 0u;
#pragma unroll
        for (unsigned j = 0; j < 16; ++j) { const unsigned c = xb_ld(&bar[XB_XCNT(j)]); sum += c; cnt += (c > 0u) ? 1u : 0u; mine = (j == x) ? c : mine; }
        if (sum == G) break;
        __builtin_amdgcn_s_sleep(1);
        if ((++sp & 255u) == 0u) { if (xb_ld(&bar[XB_TMO])) break; if (sp > XB_SPIN_CAP) { atomicAdd(&bar[XB_TMO], 1u); break; } }
    }
    nloc = mine > 0u ? mine : 1u; nx = cnt > 0u ? cnt : 1u;
}
DEVI void xcd_barrier(const XcdBarrier& b) {
    asm volatile("s_waitcnt vmcnt(0)" ::: "memory");
    __syncthreads();
    if (threadIdx.x == 0) {
        unsigned* bar = b.bar;
        __builtin_amdgcn_s_waitcnt(0);
        unsigned nloc = b.st[0], nx = b.st[1];
        if (nloc == 0u) { xcd_barrier_complete(bar, b.x, nloc, nx); b.st[0] = nloc; b.st[1] = nx; }
        const unsigned old = xb_add(&bar[XB_XSUB(b.x)], 1u);
        const unsigned gen = old / nloc;
        if (old + 1u == (gen + 1u) * nloc) {
            __builtin_amdgcn_fence(__ATOMIC_RELEASE, "agent");
            asm volatile("s_waitcnt vmcnt(0)" ::: "memory");
            const unsigned og = xb_add(&bar[XB_TOP], 1u);
            const unsigned tg = og / nx;
            if (og + 1u == (tg + 1u) * nx) xb_add(&bar[XB_TOPGEN], 1u);
            else XB_SPIN(xb_ld(&bar[XB_TOPGEN]) == tg, bar);
            __builtin_amdgcn_fence(__ATOMIC_ACQUIRE, "agent");
            xb_add(&bar[XB_XGEN(b.x)], 1u);
            asm volatile("s_waitcnt vmcnt(0)" ::: "memory");
        } else {
            XB_SPIN(xb_ld(&bar[XB_XGEN(b.x)]) == gen, bar);
            __builtin_amdgcn_fence(__ATOMIC_ACQUIRE, "agent");
            asm volatile("s_waitcnt vmcnt(0)" ::: "memory");
        }
    }
    __syncthreads();
}

template <int LO, int HI>
__global__ void __launch_bounds__(NTHREADS) fwd_kernel(const Params p) {
    extern __shared__ __align__(16) unsigned char smem[];
    XcdBarrier xb; xb.bar = (unsigned*)(p.ws + W_BAR); xb.x = 0; xb.st = (volatile PG8_LAS unsigned*)((PG8_LAS unsigned char*)smem + LDS_XB);
    if (LO < HI) {
        if (threadIdx.x == 0) { xb.st[0] = 0u; xb.st[1] = 0u; }
        __syncthreads();
        xb = xcd_barrier_post((unsigned*)(p.ws + W_BAR), xb.st);
    }
    if (LO <= 0 && 0 <= HI) { run_phase<0>(p, smem); if (0 < HI) { if (p.out == nullptr) cg::this_grid().sync(); else xcd_barrier(xb); } }
    if (LO <= 1 && 1 <= HI) { run_phase<1>(p, smem); if (1 < HI) xcd_barrier(xb); }
    if (LO <= 2 && 2 <= HI) { run_phase<2>(p, smem); if (2 < HI) xcd_barrier(xb); }
    if (LO <= 3 && 3 <= HI) { run_phase<3>(p, smem); if (3 < HI) xcd_barrier(xb); }
    if (LO <= 4 && 4 <= HI) { run_phase<4>(p, smem); if (4 < HI) xcd_barrier(xb); }
    if (LO <= 5 && 5 <= HI) { run_phase<5>(p, smem); }
}

#ifndef MK_COOP
#define MK_COOP 1
#endif

template <int LO, int HI>
static void launch_range(const Params& p, int grid, hipStream_t stream, bool coop) {
    auto kfn = fwd_kernel<LO, HI>;
    static bool attr_set = false;
    if (!attr_set) { (void)hipFuncSetAttribute((const void*)kfn, hipFuncAttributeMaxDynamicSharedMemorySize, LDS_BYTES); attr_set = true; }
    if (coop) {
        Params pl = p;
        void* args[] = {&pl};
        hipError_t e = hipLaunchCooperativeKernel((const void*)kfn, dim3(grid), dim3(NTHREADS), args, LDS_BYTES, stream);
        if (e != hipSuccess) fprintf(stderr, "cooperative launch failed: %s (grid %d)\n", hipGetErrorString(e), grid);
    } else {
        hipLaunchKernelGGL(kfn, dim3(grid), dim3(NTHREADS), LDS_BYTES, stream, p);
    }
}

extern "C" void kernel_launch(void* const* d_in, const int* in_sizes, int n_in, void* d_out, int out_size, void* d_ws, size_t ws_size, hipStream_t stream) {
    (void)in_sizes; (void)n_in; (void)out_size;
    static int grid_blocks = 0;
    if (!grid_blocks) {
        int dev = 0, cus = 0;
        (void)hipGetDevice(&dev);
        (void)hipDeviceGetAttribute(&cus, hipDeviceAttributeMultiprocessorCount, dev);
        grid_blocks = cus > 0 ? cus : 256;
        if (ws_size < W_END) fprintf(stderr, "workspace too small: %zu < %zu\n", ws_size, (size_t)W_END);
    }
    Params p{};
    p.x_p = (const float*)d_in[0]; p.x_s = (const float*)d_in[1]; p.ca_k = (const float*)d_in[2]; p.ca_v = (const float*)d_in[3];
    p.c_ik = (const float*)d_in[4]; p.cb_k = (const float*)d_in[5]; p.cb_v = (const float*)d_in[6]; p.norm_g = (const float*)d_in[7];
    p.w_in = (const float*)d_in[8]; p.qn_g = (const float*)d_in[9]; p.kn_g = (const float*)d_in[10]; p.ikn_g = (const float*)d_in[11];
    p.w_a = (const float*)d_in[12]; p.w_b = (const float*)d_in[13]; p.w_o = (const float*)d_in[14];
    p.out = (float*)d_out; p.ws = (unsigned char*)d_ws;
#if MK_COOP
    (void)hipMemsetAsync((unsigned char*)d_ws + W_BAR, 0, 16384, stream);
    launch_range<0, 5>(p, grid_blocks, stream, true);
#else
    launch_range<0, 0>(p, grid_blocks, stream, false);
    launch_range<1, 1>(p, grid_blocks, stream, false);
    launch_range<2, 2>(p, grid_blocks, stream, false);
    launch_range<3, 3>(p, grid_blocks, stream, false);
    launch_range<4, 4>(p, grid_blocks, stream, false);
    launch_range<5, 5>(p, grid_blocks, stream, false);
#endif
}
```

```cpp
#include <hip/hip_runtime.h>
#include <hip/hip_cooperative_groups.h>
#include <cstdio>
#include <cstdint>
namespace cg = cooperative_groups;

#define DEVI __device__ __forceinline__
typedef unsigned short bf16_t;
typedef short bf16x8 __attribute__((ext_vector_type(8)));
typedef float f32x4 __attribute__((ext_vector_type(4)));
typedef unsigned u32x4 __attribute__((ext_vector_type(4)));
typedef unsigned u32x2 __attribute__((ext_vector_type(2)));

constexpr int NTP = 32768, NTS = 1024, NTOK = 33792;
constexpr int NIN = 6728, NPADC = 6912;
constexpr int NTHREADS = 512;
constexpr size_t O_AKP = 34603008, O_AVP = 51380224, O_IKP = 68157440, O_BKP = 70254592, O_BVP = 87031808;
constexpr size_t O_AKS = 103809024, O_AVS = 104333312, O_IKS = 104857600, O_BKS = 104923136, O_BVS = 105447424;
constexpr size_t SZ_TOK1024 = (size_t)NTOK * 1024 * 2, SZ_TOK512 = (size_t)NTOK * 512 * 2, SZ_P512 = (size_t)NTP * 512 * 2;
constexpr size_t W_XN = 0;
constexpr size_t W_WINT = W_XN + SZ_TOK1024;
constexpr size_t W_WABT = W_WINT + (size_t)NPADC * 1024 * 2;
constexpr size_t W_WOT = W_WABT + 1024 * 1024 * 2;
constexpr size_t W_ROPE = W_WOT + 1024 * 1024 * 2;
constexpr size_t W_QA = W_ROPE + 4096 * 8 * 4 * 2;
constexpr size_t W_SUA = W_QA + SZ_TOK512;
constexpr size_t W_QI = W_SUA + SZ_TOK512;
constexpr size_t W_QB = W_QI + SZ_TOK512;
constexpr size_t W_SUB = W_QB + SZ_TOK512;
constexpr size_t W_WI = W_SUB + SZ_TOK512;
constexpr size_t W_KAP = W_WI + (size_t)NTOK * 8 * 4;
constexpr size_t W_VAP = W_KAP + SZ_P512;
constexpr size_t W_KBP = W_VAP + SZ_P512;
constexpr size_t W_VBP = W_KBP + SZ_P512;
constexpr size_t W_KIP = W_VBP + SZ_P512;
constexpr size_t W_MASK = W_KIP + (size_t)NTP * 64 * 2;
constexpr size_t W_OAB = W_MASK + (size_t)NTOK * 256 * 2;
constexpr size_t W_BAR = W_OAB + SZ_TOK1024;
constexpr size_t W_END = W_BAR + 16384;

constexpr int LDS_XB = 16 * 1040 + 16 * 2052 * 4;
constexpr int LDS_BYTES = LDS_XB + 16;

struct Params {
    const float *x_p, *x_s, *ca_k, *ca_v, *c_ik, *cb_k, *cb_v, *norm_g, *w_in, *qn_g, *kn_g, *ikn_g, *w_a, *w_b, *w_o;
    float* out;
    unsigned char* ws;
};

typedef float f32x2_t __attribute__((ext_vector_type(2)));
typedef __bf16 bf16x2_t __attribute__((ext_vector_type(2)));
DEVI unsigned pk_bf16(float lo, float hi) { const f32x2_t v = {lo, hi}; const bf16x2_t b = __builtin_convertvector(v, bf16x2_t); return __builtin_bit_cast(unsigned, b); }
DEVI float bf_lo(unsigned u) { return __uint_as_float(u << 16); }
DEVI float bf_hi(unsigned u) { return __uint_as_float(u & 0xffff0000u); }
DEVI float shx(float v, int m) { return __shfl_xor(v, m); }
DEVI f32x4 mfma16(bf16x8 a, bf16x8 b, f32x4 c) { return __builtin_amdgcn_mfma_f32_16x16x32_bf16(a, b, c, 0, 0, 0); }
DEVI float relu_(float x) { const int b = __float_as_int(x); return __int_as_float(b > 0 ? b : 0); }
DEVI float sigmoidf_(float x) { return __builtin_amdgcn_rcpf(1.0f + __expf(-x)); }
DEVI int tok_pos(int tok) { return tok < NTP ? (tok & 4095) : 2048 + ((tok - NTP) & 31); }

DEVI void transpose_job(const float* src, int lds, int k0, int ncol0, int nvalid, bf16_t* dst, int dstK, int drow0, int permslab, float* T, int lane) {
    const int r = lane >> 4, c4 = lane & 15;
    float4 v[8];
#pragma unroll
    for (int j = 0; j < 8; ++j) {
        v[j] = make_float4(0.f, 0.f, 0.f, 0.f);
        if (4 * c4 < nvalid) v[j] = *(const float4*)(src + (size_t)(k0 + r + 4 * j) * lds + ncol0 + 4 * c4);
    }
#pragma unroll
    for (int j = 0; j < 8; ++j) { float* t = T + (r + 4 * j) * 65 + 4 * c4; t[0] = v[j].x; t[1] = v[j].y; t[2] = v[j].z; t[3] = v[j].w; }
    __builtin_amdgcn_wave_barrier();
    asm volatile("s_waitcnt lgkmcnt(0)" ::: "memory");
    const int n = lane;
    const int drow = (permslab < 0) ? (drow0 + n) : (256 * (permslab >> 2) + 128 * (n >> 5) + 32 * (permslab & 3) + (n & 31));
    bf16_t* dp = dst + (size_t)drow * dstK + k0;
#pragma unroll
    for (int q = 0; q < 4; ++q) {
        float e[8];
#pragma unroll
        for (int i = 0; i < 8; ++i) e[i] = T[(8 * q + i) * 65 + n];
        u32x4 o; o.x = pk_bf16(e[0], e[1]); o.y = pk_bf16(e[2], e[3]); o.z = pk_bf16(e[4], e[5]); o.w = pk_bf16(e[6], e[7]);
        *(u32x4*)(dp + 8 * q) = o;
    }
    __builtin_amdgcn_wave_barrier();
    asm volatile("s_waitcnt lgkmcnt(0)" ::: "memory");
}

DEVI void phase0(const Params& p, unsigned char* smem) {
    int tid = threadIdx.x; asm volatile("" : "+v"(tid));
    const int lane = tid & 63, wave = tid >> 6;
    bf16_t* XN = (bf16_t*)(p.ws + W_XN);
    const int rstep = gridDim.x * 8;
    for (int row = blockIdx.x * 8 + wave; row < NTOK; row += 2 * rstep) {
        const int row2 = row + rstep;
        const bool has2 = row2 < NTOK;
        const float* xa = (row < NTP) ? p.x_p + (size_t)row * 1024 : p.x_s + (size_t)(row - NTP) * 1024;
        const int r2c = has2 ? row2 : row;
        const float* xb = (r2c < NTP) ? p.x_p + (size_t)r2c * 1024 : p.x_s + (size_t)(r2c - NTP) * 1024;
        float4 va[4], vb[4]; float sa = 0.f, sb = 0.f;
#pragma unroll
        for (int i = 0; i < 4; ++i) { va[i] = *(const float4*)(xa + i * 256 + lane * 4); vb[i] = *(const float4*)(xb + i * 256 + lane * 4); }
#pragma unroll
        for (int i = 0; i < 4; ++i) { sa += va[i].x * va[i].x + va[i].y * va[i].y + va[i].z * va[i].z + va[i].w * va[i].w; sb += vb[i].x * vb[i].x + vb[i].y * vb[i].y + vb[i].z * vb[i].z + vb[i].w * vb[i].w; }
#pragma unroll
        for (int m = 32; m >= 1; m >>= 1) { sa += shx(sa, m); sb += shx(sb, m); }
        const float ra = rsqrtf(sa * (1.0f / 1024.0f) + 1e-6f), rb = rsqrtf(sb * (1.0f / 1024.0f) + 1e-6f);
#pragma unroll
        for (int i = 0; i < 4; ++i) {
            const float4 gg = *(const float4*)(p.norm_g + i * 256 + lane * 4);
            u32x2 o; o.x = pk_bf16(va[i].x * ra * gg.x, va[i].y * ra * gg.y); o.y = pk_bf16(va[i].z * ra * gg.z, va[i].w * ra * gg.w);
            *(u32x2*)(XN + (size_t)row * 1024 + i * 256 + lane * 4) = o;
            if (has2) { u32x2 o2; o2.x = pk_bf16(vb[i].x * rb * gg.x, vb[i].y * rb * gg.y); o2.y = pk_bf16(vb[i].z * rb * gg.z, vb[i].w * rb * gg.w);
                *(u32x2*)(XN + (size_t)row2 * 1024 + i * 256 + lane * 4) = o2; }
        }
    }
    bf16_t* WINT = (bf16_t*)(p.ws + W_WINT); bf16_t* WAT = (bf16_t*)(p.ws + W_WABT); bf16_t* WBT = WAT + 1024 * 512; bf16_t* WOT = (bf16_t*)(p.ws + W_WOT);
    float* T = (float*)smem + wave * (32 * 65);
    const int NJ_IN = 32 * 106, NJ_A = 16 * 16, NJ_O = 32 * 16;
    for (int job = blockIdx.x * 8 + wave; job < NJ_IN + 2 * NJ_A + NJ_O; job += gridDim.x * 8) {
        if (job < NJ_IN) {
            const int kt = job & 31, sl = job >> 5;
            const int np0 = sl * 64;
            int ncol0, nvalid;
            if (np0 < 2624) { ncol0 = np0; nvalid = 64; }
            else if (np0 == 2624) { ncol0 = 2624; nvalid = 8; }
            else { ncol0 = np0 - 56; nvalid = 64; }
            transpose_job(p.w_in, NIN, kt * 32, ncol0, nvalid, WINT, 1024, 0, sl, T, lane);
        } else if (job < NJ_IN + NJ_A) {
            const int j = job - NJ_IN; const int kt = j & 15, ntl = j >> 4;
            transpose_job(p.w_a, 1024, kt * 32, ntl * 64, 64, WAT, 512, ntl * 64, -1, T, lane);
        } else if (job < NJ_IN + 2 * NJ_A) {
            const int j = job - NJ_IN - NJ_A; const int kt = j & 15, ntl = j >> 4;
            transpose_job(p.w_b, 1024, kt * 32, ntl * 64, 64, WBT, 512, ntl * 64, -1, T, lane);
        } else {
            const int j = job - NJ_IN - 2 * NJ_A; const int kt = j & 31, ntl = j >> 5;
            transpose_job(p.w_o, 1024, kt * 32, ntl * 64, 64, WOT, 1024, ntl * 64, -1, T, lane);
        }
    }
    float* RC = (float*)(p.ws + W_ROPE); float* RS = RC + 4096 * 8;
    for (int idx = (gridDim.x - 1 - blockIdx.x) * NTHREADS + tid; idx < 4096 * 8; idx += gridDim.x * NTHREADS) {
        const int pos = idx >> 3, i = idx & 7;
        const float inv = (i == 0) ? 1.0f : (i == 1) ? 0.19392274f : (i == 2) ? 0.03760603f : (i == 3) ? 0.0072926646f : (i == 4) ? 0.0014142136f : (i == 5) ? 0.0002742482f : (i == 6) ? 5.3182957e-05f : 1.0313385e-05f;
        const float ang = (float)pos * inv;
        RC[idx] = (float)cos((double)ang); RS[idx] = (float)sin((double)ang);
    }
    __syncthreads();
}

namespace pg8 {
#define PG8_LAS __attribute__((address_space(3)))
constexpr int BM = 256, BK = 64, HALF = 128, HTB = HALF * BK * 2, STAGE_BYTES = 8 * HTB;
__host__ __device__ __forceinline__ int lds_byte(int r, int c) { const int st = (r >> 4) * 2 + (c >> 5), rr = r & 15, cc = c & 31, ob = rr * 64 + cc * 2; return st * 1024 + (ob ^ (((ob >> 9) & 1) << 5)); }
__host__ __device__ __forceinline__ void stage_rc(int b, int& R, int& C) { const int st = b / 1024, sb = b % 1024, swz = sb ^ (((sb >> 9) & 1) << 5); R = (st >> 1) * 16 + swz / 64; C = (st & 1) * 32 + (swz % 64) / 2; }
struct Unit { int pm, pn, w; };
struct Gemm { const bf16_t* A; const bf16_t* Bt; const bf16_t* A2; const bf16_t* Bt2; int K; };

template <class Epi, class Sched>
__device__ __forceinline__ void gemm_phase(PG8_LAS unsigned char* lds, const Gemm g, const Sched& S, const Epi& E) {
    int tid = threadIdx.x; asm volatile("" : "+v"(tid));
    const int wid = __builtin_amdgcn_readfirstlane(tid >> 6), lane = tid & 63, wr = wid >> 2, wc = wid & 3, fr = lane & 15, fq = lane >> 4;
    const int K = g.K, nt = K / BK;
    unsigned voffA[2];
#pragma unroll
    for (int i = 0; i < 2; ++i) { int R, C; stage_rc(tid * 16 + i * 8192, R, C); voffA[i] = (unsigned)(R * K + C) * 2u; }
    const size_t kstep = (size_t)(BK * 2);
    const size_t hstep = (size_t)HALF * K * 2;
    const size_t tstep = 2 * hstep;
    const unsigned ldsw = (unsigned)wid * 1024u;
    const int aoff = lds_byte(wr * 64 + fr, fq * 8), boff = lds_byte(wc * 32 + fr, fq * 8);
#define PG8_SA(b, h) (((b) * 2 + (h)) * HTB)
#define PG8_SB(b, h) ((4 + (b) * 2 + (h)) * HTB)
#define PG8_STAGE(bufoff, gbase, voff) do { _Pragma("unroll") for (int _i = 0; _i < 2; ++_i) \
        __builtin_amdgcn_global_load_lds((const unsigned*)((const char*)(gbase) + (voff)[_i]), (PG8_LAS unsigned*)(lds + (bufoff) + ldsw + _i * 8192), 16, 0, 0); } while (0)
#define PG8_LDA(dst, b, h) do { _Pragma("unroll") for (int m = 0; m < 4; ++m) _Pragma("unroll") for (int k = 0; k < 2; ++k) dst[m][k] = *(const PG8_LAS bf16x8*)(lds + PG8_SA(b, h) + aoff + m * 2048 + k * 1024); } while (0)
#define PG8_LDB(dst, b, h) do { _Pragma("unroll") for (int n = 0; n < 2; ++n) _Pragma("unroll") for (int k = 0; k < 2; ++k) dst[n][k] = *(const PG8_LAS bf16x8*)(lds + PG8_SB(b, h) + boff + n * 2048 + k * 1024); } while (0)
#define PG8_MMA(ai, bj, At, Bt) do { __builtin_amdgcn_s_setprio(1); _Pragma("unroll") for (int m = 0; m < 4; ++m) _Pragma("unroll") for (int n = 0; n < 2; ++n) _Pragma("unroll") for (int k = 0; k < 2; ++k) \
        acc[ai][bj][m][n] = __builtin_amdgcn_mfma_f32_16x16x32_bf16(Bt[n][k], At[m][k], acc[ai][bj][m][n], 0, 0, 0); __builtin_amdgcn_s_setprio(0); } while (0)
#define PG8_WAIT_V(n) asm volatile("s_waitcnt vmcnt(" #n ")" ::: "memory")
#define PG8_WAIT_L(n) asm volatile("s_waitcnt lgkmcnt(" #n ")" ::: "memory")
#define PG8_BAR __builtin_amdgcn_s_barrier()
#define PG8_SCHED __builtin_amdgcn_sched_barrier(0)
    Unit cur, nxt; int ui = 0;
    if (!S.next(0, cur)) return;
    f32x4 acc[2][2][4][2];
#pragma unroll
    for (int a = 0; a < 2; ++a)
#pragma unroll
        for (int b = 0; b < 2; ++b)
#pragma unroll
            for (int m = 0; m < 4; ++m)
#pragma unroll
                for (int n = 0; n < 2; ++n) acc[a][b][m][n] = (f32x4){0.f, 0.f, 0.f, 0.f};
    bf16x8 At[4][2], B0[2][2], B1[2][2];
    const char* cA = (const char*)(cur.w ? g.A2 : g.A) + (size_t)cur.pm * tstep; const char* cB = (const char*)(cur.w ? g.Bt2 : g.Bt) + (size_t)cur.pn * tstep;
    PG8_STAGE(PG8_SB(0, 0), cB, voffA); PG8_STAGE(PG8_SB(0, 1), cB + hstep, voffA); PG8_STAGE(PG8_SA(0, 0), cA, voffA); PG8_STAGE(PG8_SA(0, 1), cA + hstep, voffA);
    if (wr == 1) PG8_BAR;
    PG8_WAIT_V(2); PG8_BAR;
    PG8_STAGE(PG8_SB(1, 0), cB + kstep, voffA); PG8_STAGE(PG8_SA(1, 0), cA + kstep, voffA); PG8_STAGE(PG8_SB(1, 1), cB + hstep + kstep, voffA);
    PG8_WAIT_V(6); PG8_BAR;
    for (;;) {
        const bool has_next = S.next(ui + 1, nxt);
        const char* nA = has_next ? (const char*)(nxt.w ? g.A2 : g.A) + (size_t)nxt.pm * tstep : cA; const char* nB = has_next ? (const char*)(nxt.w ? g.Bt2 : g.Bt) + (size_t)nxt.pn * tstep : cB;
        for (int t = 0; t < nt; t += 2) {
            const bool last = (t == nt - 2);
            const char* a1 = cA + (size_t)(t + 1) * kstep;
            const char* a2 = last ? nA : cA + (size_t)(t + 2) * kstep; const char* b2 = last ? nB : cB + (size_t)(t + 2) * kstep;
            const char* a3 = a2 + kstep; const char* b3 = b2 + kstep;
            PG8_LDB(B0, 0, 0); PG8_LDB(B1, 0, 1); PG8_SCHED; PG8_LDA(At, 0, 0); PG8_STAGE(PG8_SA(1, 1), a1 + hstep, voffA);
            PG8_WAIT_V(8); PG8_WAIT_L(0); PG8_BAR; PG8_MMA(0, 0, At, B0); PG8_MMA(0, 1, At, B1); PG8_BAR; PG8_SCHED;
            PG8_LDA(At, 0, 1); PG8_STAGE(PG8_SB(0, 0), b2, voffA); PG8_STAGE(PG8_SB(0, 1), b2 + hstep, voffA); PG8_STAGE(PG8_SA(0, 0), a2, voffA);
            PG8_WAIT_V(8); PG8_WAIT_L(0); PG8_BAR; PG8_MMA(1, 0, At, B0); PG8_MMA(1, 1, At, B1); PG8_BAR; PG8_SCHED;
            PG8_LDB(B0, 1, 0); PG8_LDB(B1, 1, 1); PG8_SCHED; PG8_LDA(At, 1, 0); PG8_STAGE(PG8_SA(0, 1), a2 + hstep, voffA);
            PG8_WAIT_V(8); PG8_WAIT_L(0); PG8_BAR; PG8_MMA(0, 0, At, B0); PG8_MMA(0, 1, At, B1); PG8_BAR; PG8_SCHED;
            PG8_LDA(At, 1, 1); PG8_STAGE(PG8_SB(1, 0), b3, voffA); PG8_STAGE(PG8_SB(1, 1), b3 + hstep, voffA); PG8_STAGE(PG8_SA(1, 0), a3, voffA);
            PG8_WAIT_V(8); PG8_WAIT_L(0); PG8_BAR; PG8_MMA(1, 0, At, B0); PG8_MMA(1, 1, At, B1); PG8_BAR; PG8_SCHED;
        }
        if (wr == 0) PG8_BAR;
        E(acc, cur, wr, wc, fr, fq);
        if (!has_next) break;
#pragma unroll
        for (int a = 0; a < 2; ++a)
#pragma unroll
            for (int b = 0; b < 2; ++b)
#pragma unroll
                for (int m = 0; m < 4; ++m)
#pragma unroll
                    for (int n = 0; n < 2; ++n) acc[a][b][m][n] = (f32x4){0.f, 0.f, 0.f, 0.f};
        cur = nxt; cA = nA; cB = nB; ++ui;
        if (wr == 1) PG8_BAR;
    }
    PG8_WAIT_V(0);
    PG8_BAR;
#undef PG8_SA
#undef PG8_SB
#undef PG8_STAGE
#undef PG8_LDA
#undef PG8_LDB
#undef PG8_MMA
#undef PG8_WAIT_V
#undef PG8_WAIT_L
#undef PG8_BAR
#undef PG8_SCHED
}
}

struct OrderP1 {
    int x, j, nloc, G;
    DEVI void init() { G = gridDim.x; const int b = blockIdx.x; if ((G & 7) == 0) { x = b & 7; j = b >> 3; nloc = G >> 3; } else { x = -1; j = b; nloc = G; } }
    DEVI bool next(int i, pg8::Unit& u) const {
        const int T = 132 * 27;
        int idx;
        if (x >= 0) { const int s0 = (x * T) >> 3, s1 = ((x + 1) * T) >> 3; idx = s0 + i * nloc + j; if (idx >= s1) return false; }
        else { idx = j + i * G; if (idx >= T) return false; }
        const int mg = idx / 108, rem = idx - mg * 108;
        u.pm = mg * 4 + (rem & 3); u.pn = rem >> 2; u.w = 0; return true;
    }
};
struct OrderP4 {
    int x, j, nloc, G; bool pair;
    DEVI void init(bool pr) { pair = pr; G = gridDim.x; const int b = blockIdx.x; if ((G & 7) == 0) { x = b & 7; j = b >> 3; nloc = G >> 3; } else { x = -1; j = b; nloc = G; } }
    DEVI bool next(int i, pg8::Unit& u) const {
        const int T = 128 * 4;
        const int ii = pair ? (i >> 1) : i;
        int idx;
        if (x >= 0) { const int s0 = (x * T) >> 3, s1 = ((x + 1) * T) >> 3; idx = s0 + ii * nloc + j; if (idx >= s1) return false; }
        else { idx = j + ii * G; if (idx >= T) return false; }
        u.pm = idx >> 2; u.pn = idx & 3; u.w = pair ? (i & 1) : 0; return true;
    }
};

struct EpiProj {
    const Params* pp;
    DEVI void operator()(const f32x4 (&acc)[2][2][4][2], const pg8::Unit& u, int wr, int wc, int l15, int g) const {
        const Params& p = *pp;
        const int slab = 4 * u.pn + wc;
        if (slab >= 106) return;
        const int m0 = u.pm * 256;
        const bool prompt = m0 < NTP;
        const int tokb = m0 + 64 * wr + l15;
        if (slab == 41) {
            if (g < 2) {
                float* WI = (float*)(p.ws + W_WI);
#pragma unroll
                for (int ai = 0; ai < 2; ++ai)
#pragma unroll
                    for (int m = 0; m < 4; ++m) {
                        const f32x4 v = acc[ai][0][m][0] * 0.35355339059327373f;
                        *(f32x4*)(WI + (size_t)(tokb + 128 * ai + 16 * m) * 8 + 4 * g) = v;
                    }
            }
            return;
        }
        const float* gain = nullptr; bool rope = false; int act = 0;
        float* fdst = nullptr; int fw = 0; bf16_t* bdst = nullptr; int bw = 512; bool bprompt = false; int colo = 0;
        float oscale = 1.0f;
        if (slab < 8) { gain = p.qn_g; rope = true; bdst = (bf16_t*)(p.ws + W_QA); colo = slab * 64; oscale = 0.125f * 1.4426950408889634f; }
        else if (slab < 16) { gain = p.kn_g; rope = true; fdst = p.out + (prompt ? O_AKP : O_AKS); fw = 512; bdst = (bf16_t*)(p.ws + W_KAP); bprompt = true; colo = (slab - 8) * 64; }
        else if (slab < 24) { fdst = p.out + (prompt ? O_AVP : O_AVS); fw = 512; bdst = (bf16_t*)(p.ws + W_VAP); bprompt = true; colo = (slab - 16) * 64; }
        else if (slab < 32) { act = 1; bdst = (bf16_t*)(p.ws + W_SUA); colo = (slab - 24) * 64; }
        else if (slab < 40) { rope = true; bdst = (bf16_t*)(p.ws + W_QI); colo = (slab - 32) * 64; }
        else if (slab == 40) { gain = p.ikn_g; rope = true; fdst = p.out + (prompt ? O_IKP : O_IKS); fw = 64; bdst = (bf16_t*)(p.ws + W_KIP); bw = 64; bprompt = true; colo = 0; }
        else if (slab < 50) { bdst = (bf16_t*)(p.ws + W_QB); colo = (slab - 42) * 64; oscale = -0.125f * 1.4426950408889634f; }
        else if (slab < 58) { fdst = p.out + (prompt ? O_BKP : O_BKS); fw = 512; bdst = (bf16_t*)(p.ws + W_KBP); bprompt = true; colo = (slab - 50) * 64; }
        else if (slab < 66) { fdst = p.out + (prompt ? O_BVP : O_BVS); fw = 512; bdst = (bf16_t*)(p.ws + W_VBP); bprompt = true; colo = (slab - 58) * 64; }
        else if (slab < 74) { act = 1; bdst = (bf16_t*)(p.ws + W_SUB); colo = (slab - 66) * 64; }
        else if (slab < 90) { act = 2; bdst = (bf16_t*)p.out; bw = 2048; colo = (slab - 74) * 64; }
        else { act = 2; bdst = (bf16_t*)p.out; bw = 2048; colo = 1024 + (slab - 90) * 64; }
        f32x4 gv[4];
        if (gain) {
#pragma unroll
            for (int nt = 0; nt < 4; ++nt) gv[nt] = *(const f32x4*)(gain + 16 * nt + 4 * g);
        }
        const float* RC = (const float*)(p.ws + W_ROPE); const float* RS = RC + 4096 * 8;
        const bool wb = bdst && (!bprompt || prompt);
#pragma unroll
        for (int ai = 0; ai < 2; ++ai) {
        f32x4 ropc[4], rops[4];
        if (rope) {
#pragma unroll
            for (int q = 0; q < 4; ++q) {
                const int pos = tok_pos(tokb + 128 * ai + 16 * q);
                ropc[q] = *(const f32x4*)(RC + pos * 8 + 4 * (g & 1));
                rops[q] = *(const f32x4*)(RS + pos * 8 + 4 * (g & 1));
            }
        }
#pragma unroll
        for (int m = 0; m < 4; ++m) {
            const int tok = tokb + 128 * ai + 16 * m;
            f32x4 v[4];
#pragma unroll
            for (int nt = 0; nt < 4; ++nt) v[nt] = acc[ai][nt >> 1][m][nt & 1];
            if (gain) {
                float ss = 0.f;
#pragma unroll
                for (int nt = 0; nt < 4; ++nt) ss += v[nt][0] * v[nt][0] + v[nt][1] * v[nt][1] + v[nt][2] * v[nt][2] + v[nt][3] * v[nt][3];
                ss += shx(ss, 16); ss += shx(ss, 32);
                const float rs = rsqrtf(ss * (1.0f / 64.0f) + 1e-6f);
#pragma unroll
                for (int nt = 0; nt < 4; ++nt) v[nt] = v[nt] * rs * gv[nt];
            }
            if (rope) {
                const f32x4 c4 = ropc[m], s4 = rops[m];
                f32x4 o;
#pragma unroll
                for (int r = 0; r < 4; ++r) {
                    const float me = v[0][r], pr = shx(me, 32);
                    o[r] = (g < 2) ? (me * c4[r] - pr * s4[r]) : (me * c4[r] + pr * s4[r]);
                }
                v[0] = o;
            }
            if (slab < 8 || (slab >= 42 && slab < 50)) {
#pragma unroll
                for (int nt = 0; nt < 4; ++nt) v[nt] = v[nt] * oscale;
            }
            if (act == 1) {
#pragma unroll
                for (int nt = 0; nt < 4; ++nt)
#pragma unroll
                    for (int r = 0; r < 4; ++r) v[nt][r] = v[nt][r] * sigmoidf_(v[nt][r]);
            } else if (act == 2) {
#pragma unroll
                for (int nt = 0; nt < 4; ++nt)
#pragma unroll
                    for (int r = 0; r < 4; ++r) v[nt][r] = sigmoidf_(v[nt][r]);
            }
            if (fdst) {
                float* fp = fdst + (size_t)(prompt ? tok : tok - NTP) * fw + colo + 4 * g;
#pragma unroll
                for (int nt = 0; nt < 4; ++nt) *(f32x4*)(fp + 16 * nt) = v[nt];
            }
            if (wb) {
                bf16_t* bp = bdst + (size_t)tok * bw + colo + 16 * (g & 1) + 8 * (g >> 1);
#pragma unroll
                for (int pr = 0; pr < 2; ++pr) {
                    const unsigned x0 = pk_bf16(v[2 * pr][0], v[2 * pr][1]), x1 = pk_bf16(v[2 * pr][2], v[2 * pr][3]);
                    const unsigned y0 = pk_bf16(v[2 * pr + 1][0], v[2 * pr + 1][1]), y1 = pk_bf16(v[2 * pr + 1][2], v[2 * pr + 1][3]);
                    const auto r0 = __builtin_amdgcn_permlane16_swap(x0, y0, false, false);
                    const auto r1 = __builtin_amdgcn_permlane16_swap(x1, y1, false, false);
                    const u32x4 o = (u32x4){r0[0], r1[0], r0[1], r1[1]};
                    *(u32x4*)(bp + 32 * pr) = o;
                }
            }
        }
        }
    }
};

struct EpiMix {
    const Params* pp;
    DEVI void operator()(const f32x4 (&acc)[2][2][4][2], const pg8::Unit& u, int wr, int wc, int l15, int g) const {
        const bf16_t* G = (const bf16_t*)pp->out;
        bf16_t* MX = (bf16_t*)(pp->ws + W_XN);
        const int colb = u.pn * 256 + 32 * wc + 4 * g;
#pragma unroll
        for (int ai = 0; ai < 2; ++ai)
#pragma unroll
        for (int mh = 0; mh < 2; ++mh) {
            u32x2 gq[4][2][2], pv[4][2][2];
#pragma unroll
            for (int m = 2 * mh; m < 2 * mh + 2; ++m) {
                const int tok = u.pm * 256 + 128 * ai + 64 * wr + 16 * m + l15;
#pragma unroll
                for (int bj = 0; bj < 2; ++bj)
#pragma unroll
                    for (int n = 0; n < 2; ++n) {
                        const int col = colb + 128 * bj + 16 * n;
                        gq[m][bj][n] = *(const u32x2*)(G + (size_t)tok * 2048 + (u.w ? 1024 : 0) + col);
                        if (u.w) pv[m][bj][n] = *(const u32x2*)(MX + (size_t)tok * 1024 + col);
                    }
            }
#pragma unroll
            for (int m = 2 * mh; m < 2 * mh + 2; ++m) {
                const int tok = u.pm * 256 + 128 * ai + 64 * wr + 16 * m + l15;
#pragma unroll
                for (int bj = 0; bj < 2; ++bj) {
                    unsigned pk[2][2];
#pragma unroll
                    for (int n = 0; n < 2; ++n) {
                        const f32x4 a = acc[ai][bj][m][n];
                        const u32x2 gg = gq[m][bj][n];
                        f32x4 t;
                        t[0] = a[0] * bf_lo(gg.x); t[1] = a[1] * bf_hi(gg.x); t[2] = a[2] * bf_lo(gg.y); t[3] = a[3] * bf_hi(gg.y);
                        if (u.w) { const u32x2 q = pv[m][bj][n]; t[0] += bf_lo(q.x); t[1] += bf_hi(q.x); t[2] += bf_lo(q.y); t[3] += bf_hi(q.y); }
                        pk[n][0] = pk_bf16(t[0], t[1]); pk[n][1] = pk_bf16(t[2], t[3]);
                    }
                    const auto r0 = __builtin_amdgcn_permlane16_swap(pk[0][0], pk[1][0], false, false);
                    const auto r1 = __builtin_amdgcn_permlane16_swap(pk[0][1], pk[1][1], false, false);
                    const u32x4 o = (u32x4){r0[0], r1[0], r0[1], r1[1]};
                    *(u32x4*)(MX + (size_t)tok * 1024 + u.pn * 256 + 32 * wc + 128 * bj + 16 * (g & 1) + 8 * (g >> 1)) = o;
                }
            }
        }
    }
};

struct EpiY {
    const Params* pp;
    DEVI void operator()(const f32x4 (&acc)[2][2][4][2], const pg8::Unit& u, int wr, int wc, int l15, int g) const {
        const int colb = u.pn * 256 + 32 * wc + 4 * g;
#pragma unroll
        for (int ai = 0; ai < 2; ++ai)
#pragma unroll
        for (int mh = 0; mh < 2; ++mh) {
            f32x4 xv[4][2][2];
#pragma unroll
            for (int m = 2 * mh; m < 2 * mh + 2; ++m) {
                const int tok = u.pm * 256 + 128 * ai + 64 * wr + 16 * m + l15;
                const float* xr = (tok < NTP) ? pp->x_p + (size_t)tok * 1024 : pp->x_s + (size_t)(tok - NTP) * 1024;
#pragma unroll
                for (int bj = 0; bj < 2; ++bj)
#pragma unroll
                    for (int n = 0; n < 2; ++n) xv[m][bj][n] = *(const f32x4*)(xr + colb + 128 * bj + 16 * n);
            }
#pragma unroll
            for (int m = 2 * mh; m < 2 * mh + 2; ++m) {
                const int tok = u.pm * 256 + 128 * ai + 64 * wr + 16 * m + l15;
#pragma unroll
                for (int bj = 0; bj < 2; ++bj)
#pragma unroll
                    for (int n = 0; n < 2; ++n) *(f32x4*)(pp->out + (size_t)tok * 1024 + colb + 128 * bj + 16 * n) = xv[m][bj][n] + acc[ai][bj][m][n];
            }
        }
    }
};

DEVI void mini_kloop(const bf16_t* __restrict__ arow, const bf16_t* __restrict__ b0, const bf16_t* __restrict__ b1, const int K, f32x4 (&acc)[2]) {
#pragma unroll 8
    for (int k0 = 0; k0 < K; k0 += 32) {
        const bf16x8 af = *(const bf16x8*)(arow + k0), w0 = *(const bf16x8*)(b0 + k0), w1 = *(const bf16x8*)(b1 + k0);
        acc[0] = mfma16(w0, af, acc[0]); acc[1] = mfma16(w1, af, acc[1]);
    }
}
DEVI void mini_mix_tile(const Params& p, const int t) {
    int tid = threadIdx.x; asm volatile("" : "+v"(tid));
    const int lane = tid & 63, w = tid >> 6, l15 = lane & 15, g = lane >> 4;
    const int tok = NTP + 64 * (t >> 4) + 16 * (w & 3) + l15, colw = 64 * (t & 15) + 32 * (w >> 2);
    const bf16_t* OA = (const bf16_t*)(p.ws + W_OAB); const bf16_t* OB = OA + (size_t)NTOK * 512;
    const bf16_t* WAT = (const bf16_t*)(p.ws + W_WABT); const bf16_t* WBT = WAT + 1024 * 512;
    f32x4 aa[2] = {(f32x4){0.f, 0.f, 0.f, 0.f}, (f32x4){0.f, 0.f, 0.f, 0.f}}, ab[2] = {(f32x4){0.f, 0.f, 0.f, 0.f}, (f32x4){0.f, 0.f, 0.f, 0.f}};
    mini_kloop(OA + (size_t)tok * 512 + 8 * g, WAT + (size_t)(colw + l15) * 512 + 8 * g, WAT + (size_t)(colw + 16 + l15) * 512 + 8 * g, 512, aa);
    mini_kloop(OB + (size_t)tok * 512 + 8 * g, WBT + (size_t)(colw + l15) * 512 + 8 * g, WBT + (size_t)(colw + 16 + l15) * 512 + 8 * g, 512, ab);
    const bf16_t* G = (const bf16_t*)p.out; bf16_t* MX = (bf16_t*)(p.ws + W_XN);
#pragma unroll
    for (int tt = 0; tt < 2; ++tt) {
        const int col = colw + 16 * tt + 4 * g;
        const u32x2 ga = *(const u32x2*)(G + (size_t)tok * 2048 + col), gb = *(const u32x2*)(G + (size_t)tok * 2048 + 1024 + col);
        f32x4 m;
        m[0] = aa[tt][0] * bf_lo(ga.x) + ab[tt][0] * bf_lo(gb.x); m[1] = aa[tt][1] * bf_hi(ga.x) + ab[tt][1] * bf_hi(gb.x);
        m[2] = aa[tt][2] * bf_lo(ga.y) + ab[tt][2] * bf_lo(gb.y); m[3] = aa[tt][3] * bf_hi(ga.y) + ab[tt][3] * bf_hi(gb.y);
        u32x2 o; o.x = pk_bf16(m[0], m[1]); o.y = pk_bf16(m[2], m[3]);
        *(u32x2*)(MX + (size_t)tok * 1024 + col) = o;
    }
}
DEVI void mini_y_tile(const Params& p, const int t) {
    int tid = threadIdx.x; asm volatile("" : "+v"(tid));
    const int lane = tid & 63, w = tid >> 6, l15 = lane & 15, g = lane >> 4;
    const int tok = NTP + 64 * (t >> 4) + 16 * (w & 3) + l15, colw = 64 * (t & 15) + 32 * (w >> 2);
    const bf16_t* MX = (const bf16_t*)(p.ws + W_XN); const bf16_t* WOT = (const bf16_t*)(p.ws + W_WOT);
    f32x4 acc[2] = {(f32x4){0.f, 0.f, 0.f, 0.f}, (f32x4){0.f, 0.f, 0.f, 0.f}};
    mini_kloop(MX + (size_t)tok * 1024 + 8 * g, WOT + (size_t)(colw + l15) * 1024 + 8 * g, WOT + (size_t)(colw + 16 + l15) * 1024 + 8 * g, 1024, acc);
    const float* xr = p.x_s + (size_t)(tok - NTP) * 1024;
#pragma unroll
    for (int tt = 0; tt < 2; ++tt) {
        const int col = colw + 16 * tt + 4 * g;
        const f32x4 xv = *(const f32x4*)(xr + col);
        *(f32x4*)(p.out + (size_t)tok * 1024 + col) = xv + acc[tt];
    }
}

DEVI unsigned ordkey(float x) { const unsigned u = __float_as_uint(x); return (u & 0x80000000u) ? ~u : (u | 0x80000000u); }

constexpr int TK_QS = 16 * 1040, TK_ROW = 2052;

DEVI unsigned long long cmp_ge_mask(unsigned k, unsigned mid) { unsigned long long m; asm("v_cmp_ge_u32_e64 %0, %1, %2" : "=s"(m) : "v"(k), "s"(mid)); return m; }
DEVI int count_ge8(const unsigned* k, unsigned mid) {
    unsigned long long m0, m1, m2, m3, m4, m5, m6, m7;
    int c, t1, t2, t3;
    asm("v_cmp_ge_u32_e64 %0, %12, %20\n\t"
        "v_cmp_ge_u32_e64 %1, %13, %20\n\t"
        "v_cmp_ge_u32_e64 %2, %14, %20\n\t"
        "v_cmp_ge_u32_e64 %3, %15, %20\n\t"
        "v_cmp_ge_u32_e64 %4, %16, %20\n\t"
        "v_cmp_ge_u32_e64 %5, %17, %20\n\t"
        "v_cmp_ge_u32_e64 %6, %18, %20\n\t"
        "v_cmp_ge_u32_e64 %7, %19, %20\n\t"
        "s_bcnt1_i32_b64 %8, %0\n\t"
        "s_bcnt1_i32_b64 %9, %1\n\t"
        "s_bcnt1_i32_b64 %10, %2\n\t"
        "s_bcnt1_i32_b64 %11, %3\n\t"
        "s_add_i32 %8, %8, %9\n\t"
        "s_add_i32 %10, %10, %11\n\t"
        "s_bcnt1_i32_b64 %9, %4\n\t"
        "s_bcnt1_i32_b64 %11, %5\n\t"
        "s_add_i32 %8, %8, %10\n\t"
        "s_add_i32 %9, %9, %11\n\t"
        "s_bcnt1_i32_b64 %10, %6\n\t"
        "s_bcnt1_i32_b64 %11, %7\n\t"
        "s_add_i32 %8, %8, %9\n\t"
        "s_add_i32 %10, %10, %11\n\t"
        "s_add_i32 %8, %8, %10"
        : "=&s"(m0), "=&s"(m1), "=&s"(m2), "=&s"(m3), "=&s"(m4), "=&s"(m5), "=&s"(m6), "=&s"(m7), "=&s"(c), "=&s"(t1), "=&s"(t2), "=&s"(t3)
        : "v"(k[0]), "v"(k[1]), "v"(k[2]), "v"(k[3]), "v"(k[4]), "v"(k[5]), "v"(k[6]), "v"(k[7]), "s"(mid)
        : "scc");
    return c;
}

DEVI unsigned wave_umax(unsigned v) {
    unsigned t;
    t = (unsigned)__builtin_amdgcn_update_dpp(0, (int)v, 0xB1, 0xF, 0xF, true); v = v > t ? v : t;
    t = (unsigned)__builtin_amdgcn_update_dpp(0, (int)v, 0x4E, 0xF, 0xF, true); v = v > t ? v : t;
    t = (unsigned)__builtin_amdgcn_update_dpp(0, (int)v, 0x141, 0xF, 0xF, true); v = v > t ? v : t;
    t = (unsigned)__builtin_amdgcn_update_dpp(0, (int)v, 0x140, 0xF, 0xF, true); v = v > t ? v : t;
    const unsigned a = (unsigned)__builtin_amdgcn_readlane((int)v, 0), b = (unsigned)__builtin_amdgcn_readlane((int)v, 16);
    const unsigned c = (unsigned)__builtin_amdgcn_readlane((int)v, 32), d = (unsigned)__builtin_amdgcn_readlane((int)v, 48);
    const unsigned ab = a > b ? a : b, cd = c > d ? c : d;
    return ab > cd ? ab : cd;
}
DEVI unsigned lowbits32(unsigned m, int t) {
    int p = 0;
#pragma unroll
    for (int k = 16; k >= 1; k >>= 1) { if (__builtin_popcount(m & ((1u << (p + k)) - 1u)) < t) p += k; }
    const unsigned keep = (p == 31) ? 0xFFFFFFFFu : ((2u << p) - 1u);
    return (t <= 0) ? 0u : (m & keep);
}
DEVI void topk_select2(const unsigned (&kA)[64], const unsigned (&kB)[64], const bool two, const int ng, const int lim, bf16_t* mrowA, bf16_t* mrowB, const int lane) {
    unsigned loA = 0u, hiA = 0xFFFFFFFFu, TA = 1u, loB = 0u, hiB = 0xFFFFFFFFu, TB = 1u;
    int clA = lim, chA = 0, needA = 0, clB = lim, chB = 0, needB = 0;
    bool dA = (lim <= 256), dB = dA;
    int itn = 0;
    unsigned sdA = 0xBC800000u, sdB = 0xBC800000u;
    if (!dA) {
        unsigned mA = 0u, mB = 0u;
#pragma unroll
        for (int j = 0; j < 64; ++j) if (j < 32 || two) { mA = mA > kA[j] ? mA : kA[j]; mB = mB > kB[j] ? mB : kB[j]; }
        mA = wave_umax(mA); mB = wave_umax(mB);
        hiA = mA + 1u; hiB = mB + 1u;
        if (mA > 0x80000000u + (8u << 23)) sdA = mA - (3u << 23);
        if (mB > 0x80000000u + (8u << 23)) sdB = mB - (3u << 23);
    }
    while (!(dA && dB)) {
        unsigned pa = loA + ((hiA - loA) >> 1), pb = loB + ((hiB - loB) >> 1);
        if (itn == 0) { if (sdA > loA && sdA < hiA) pa = sdA; if (sdB > loB && sdB < hiB) pb = sdB; }
        else if (itn == 1) {
            if (0xC1000000u > loA && 0xC1000000u < hiA) pa = 0xC1000000u; else if (loA == 0u && 0xBC800000u < hiA) pa = 0xBC800000u;
            if (0xC1000000u > loB && 0xC1000000u < hiB) pb = 0xC1000000u; else if (loB == 0u && 0xBC800000u < hiB) pb = 0xBC800000u;
        }
        ++itn;
        const unsigned midA = __builtin_amdgcn_readfirstlane(pa), midB = __builtin_amdgcn_readfirstlane(pb);
        int cA = 0, cB = 0;
        if (!dA) {
            cA = count_ge8(&kA[0], midA);
            if (ng > 1) cA += count_ge8(&kA[8], midA);
            if (ng > 2) cA += count_ge8(&kA[16], midA);
            if (ng > 3) cA += count_ge8(&kA[24], midA);
            if (ng > 4) cA += count_ge8(&kA[32], midA);
            if (ng > 5) cA += count_ge8(&kA[40], midA);
            if (ng > 6) cA += count_ge8(&kA[48], midA);
            if (ng > 7) cA += count_ge8(&kA[56], midA);
        }
        if (!dB) {
            cB = count_ge8(&kB[0], midB);
            if (ng > 1) cB += count_ge8(&kB[8], midB);
            if (ng > 2) cB += count_ge8(&kB[16], midB);
            if (ng > 3) cB += count_ge8(&kB[24], midB);
            if (ng > 4) cB += count_ge8(&kB[32], midB);
            if (ng > 5) cB += count_ge8(&kB[40], midB);
            if (ng > 6) cB += count_ge8(&kB[48], midB);
            if (ng > 7) cB += count_ge8(&kB[56], midB);
        }
        if (!dA) {
            if (cA >= 256) { loA = midA; clA = cA; } else { hiA = midA; chA = cA; }
            if (cA == 256) { TA = midA; needA = 0; dA = true; }
            else if (hiA - loA == 1u) { TA = loA; needA = (clA == 256) ? 0 : (256 - chA); dA = true; }
        }
        if (!dB) {
            if (cB >= 256) { loB = midB; clB = cB; } else { hiB = midB; chB = cB; }
            if (cB == 256) { TB = midB; needB = 0; dB = true; }
            else if (hiB - loB == 1u) { TB = loB; needB = (clB == 256) ? 0 : (256 - chB); dB = true; }
        }
    }
    unsigned geAl = 0, geAh = 0, geBl = 0, geBh = 0;
#pragma unroll
    for (int j = 0; j < 64; ++j) {
        if (j < 32 || two) {
            const unsigned long long a = cmp_ge_mask(kA[j], TA), bq = cmp_ge_mask(kB[j], TB);
            const bool me = (lane == j);
            geAl = me ? (unsigned)a : geAl; geAh = me ? (unsigned)(a >> 32) : geAh;
            geBl = me ? (unsigned)bq : geBl; geBh = me ? (unsigned)(bq >> 32) : geBh;
        }
    }
    if (needA > 0) {
        unsigned gtAl = 0, gtAh = 0;
        const unsigned TA1 = TA + 1u;
#pragma unroll
        for (int j = 0; j < 64; ++j) {
            if (j < 32 || two) { const unsigned long long a2 = cmp_ge_mask(kA[j], TA1); const bool me = (lane == j); gtAl = me ? (unsigned)a2 : gtAl; gtAh = me ? (unsigned)(a2 >> 32) : gtAh; }
        }
        unsigned el = geAl & ~gtAl, eh = geAh & ~gtAh;
        const int pc = __builtin_popcount(el) + __builtin_popcount(eh);
        int pre = pc;
#pragma unroll
        for (int d = 1; d < 64; d <<= 1) { const int t = __shfl_up(pre, d); if (lane >= d) pre += t; }
        int take = needA - (pre - pc); take = take < 0 ? 0 : (take > pc ? pc : take);
        const int pl = __builtin_popcount(el); const int tl = take < pl ? take : pl;
        el = lowbits32(el, tl); eh = lowbits32(eh, take - tl);
        geAl = gtAl | el; geAh = gtAh | eh;
    }
    if (needB > 0) {
        unsigned gtBl = 0, gtBh = 0;
        const unsigned TB1 = TB + 1u;
#pragma unroll
        for (int j = 0; j < 64; ++j) {
            if (j < 32 || two) { const unsigned long long b2 = cmp_ge_mask(kB[j], TB1); const bool me = (lane == j); gtBl = me ? (unsigned)b2 : gtBl; gtBh = me ? (unsigned)(b2 >> 32) : gtBh; }
        }
        unsigned el = geBl & ~gtBl, eh = geBh & ~gtBh;
        const int pc = __builtin_popcount(el) + __builtin_popcount(eh);
        int pre = pc;
#pragma unroll
        for (int d = 1; d < 64; d <<= 1) { const int t = __shfl_up(pre, d); if (lane >= d) pre += t; }
        int take = needB - (pre - pc); take = take < 0 ? 0 : (take > pc ? pc : take);
        const int pl = __builtin_popcount(el); const int tl = take < pl ? take : pl;
        el = lowbits32(el, tl); eh = lowbits32(eh, take - tl);
        geBl = gtBl | el; geBh = gtBh | eh;
    }
    u32x2 o; o.x = geAl; o.y = geAh; *(u32x2*)(mrowA + 4 * lane) = o;
    o.x = geBl; o.y = geBh; *(u32x2*)(mrowB + 4 * lane) = o;
}

DEVI void topk_unit(const Params& p, const int u, unsigned char* smem) {
    int tid = threadIdx.x; asm volatile("" : "+v"(tid));
    const int lane = tid & 63, w = tid >> 6, l15 = lane & 15, g = lane >> 4;
    int wq = w * 16 + 4 * g; asm volatile("" : "+v"(wq));
    int wl = w * 16 + l15; asm volatile("" : "+v"(wl));
    unsigned char* qs = smem;
    unsigned* KL = (unsigned*)(smem + TK_QS);
    const bool prompt = u < 2048;
    int b, tok0, lim;
    if (prompt) { b = u & 7; const int qt = u >> 3; tok0 = b * 4096 + qt * 16; lim = (((qt * 16) >> 6) + 1) * 64; }
    else { const int v = u - 2048; b = v >> 1; tok0 = NTP + b * 32 + (v & 1) * 16; lim = 2080; }
    const int ni = (lim + 127) >> 7;
    const int npair = (ni + 1) >> 1;
    const bf16_t* QI = (const bf16_t*)(p.ws + W_QI);
#pragma unroll
    for (int j = 0; j < 2; ++j) {
        const int id = tid + 512 * j, row = id >> 6, c = id & 63;
        *(u32x4*)(qs + row * 1040 + c * 16) = *(const u32x4*)(QI + (size_t)(tok0 + row) * 512 + c * 8);
    }
    float wv[8];
    {
        const float* WI = (const float*)(p.ws + W_WI) + (size_t)(tok0 + l15) * 8;
        const f32x4 a = *(const f32x4*)WI, c = *(const f32x4*)(WI + 4);
        wv[0] = a[0] * 0.125f; wv[1] = a[1] * 0.125f; wv[2] = a[2] * 0.125f; wv[3] = a[3] * 0.125f;
        wv[4] = c[0] * 0.125f; wv[5] = c[1] * 0.125f; wv[6] = c[2] * 0.125f; wv[7] = c[3] * 0.125f;
    }
    const bf16_t* KIP = (const bf16_t*)(p.ws + W_KIP) + (size_t)b * 4096 * 64 + 8 * g;
    const float* CIK = p.c_ik + (size_t)b * 2048 * 64 + 8 * g;
    const float* NIK = p.out + O_IKS + (size_t)b * 32 * 64 + 8 * g;
#define TK_LOADK(dst0, dst1, i_) do { \
        const int s_ = wl + 128 * (i_); \
        if (prompt) { const bf16_t* kp_ = KIP + (size_t)s_ * 64; dst0 = *(const u32x4*)kp_; dst1 = *(const u32x4*)(kp_ + 32); } \
        else { const int sc_ = s_ < 2079 ? s_ : 2079; const float* kp_ = (sc_ < 2048) ? CIK + (size_t)sc_ * 64 : NIK + (size_t)(sc_ - 2048) * 64; \
            const f32x4 a0_ = *(const f32x4*)kp_, a1_ = *(const f32x4*)(kp_ + 4), a2_ = *(const f32x4*)(kp_ + 32), a3_ = *(const f32x4*)(kp_ + 36); \
            dst0.x = pk_bf16(a0_[0], a0_[1]); dst0.y = pk_bf16(a0_[2], a0_[3]); dst0.z = pk_bf16(a1_[0], a1_[1]); dst0.w = pk_bf16(a1_[2], a1_[3]); \
            dst1.x = pk_bf16(a2_[0], a2_[1]); dst1.y = pk_bf16(a2_[2], a2_[3]); dst1.z = pk_bf16(a3_[0], a3_[1]); dst1.w = pk_bf16(a3_[2], a3_[3]); } } while (0)
    u32x4 ka0, ka1, kb0, kb1, na0, na1, nb0, nb1;
    TK_LOADK(ka0, ka1, 0); TK_LOADK(kb0, kb1, 1);
    na0 = ka0; na1 = ka1; nb0 = kb0; nb1 = kb1;
    __syncthreads();
    unsigned keyA[64], keyB[64];
#pragma unroll
    for (int c = 0; c < 2; ++c) {
        if (8 * c < npair) {
            const int ipe = (npair < 8 * c + 8) ? npair : (8 * c + 8);
#pragma unroll 1
            for (int ip = 8 * c; ip < ipe; ++ip) {
                if (ip + 1 < npair) { TK_LOADK(na0, na1, 2 * ip + 2); TK_LOADK(nb0, nb1, 2 * ip + 3); }
                f32x4 sa = (f32x4){0.f, 0.f, 0.f, 0.f}, sb4 = (f32x4){0.f, 0.f, 0.f, 0.f};
#pragma unroll
                for (int h = 0; h < 8; ++h) {
                    const bf16x8 q0 = *(const bf16x8*)(qs + l15 * 1040 + (h * 64 + 8 * g) * 2);
                    const bf16x8 q1 = *(const bf16x8*)(qs + l15 * 1040 + (h * 64 + 32 + 8 * g) * 2);
                    f32x4 da = mfma16(__builtin_bit_cast(bf16x8, ka0), q0, (f32x4){0.f, 0.f, 0.f, 0.f});
                    f32x4 db = mfma16(__builtin_bit_cast(bf16x8, kb0), q0, (f32x4){0.f, 0.f, 0.f, 0.f});
                    da = mfma16(__builtin_bit_cast(bf16x8, ka1), q1, da);
                    db = mfma16(__builtin_bit_cast(bf16x8, kb1), q1, db);
#pragma unroll
                    for (int r = 0; r < 4; ++r) { sa[r] = fmaf(relu_(da[r]), wv[h], sa[r]); sb4[r] = fmaf(relu_(db[r]), wv[h], sb4[r]); }
                }
                u32x4 oa, ob;
                const int sk = wq + 256 * ip;
                oa.x = (sk + 0 < lim) ? ordkey(sa[0] + 0.0f) : 0u; oa.y = (sk + 1 < lim) ? ordkey(sa[1] + 0.0f) : 0u;
                oa.z = (sk + 2 < lim) ? ordkey(sa[2] + 0.0f) : 0u; oa.w = (sk + 3 < lim) ? ordkey(sa[3] + 0.0f) : 0u;
                ob.x = (sk + 128 < lim) ? ordkey(sb4[0] + 0.0f) : 0u; ob.y = (sk + 129 < lim) ? ordkey(sb4[1] + 0.0f) : 0u;
                ob.z = (sk + 130 < lim) ? ordkey(sb4[2] + 0.0f) : 0u; ob.w = (sk + 131 < lim) ? ordkey(sb4[3] + 0.0f) : 0u;
                unsigned* kw = KL + l15 * TK_ROW + (wq + 256 * (ip - 8 * c));
                *(u32x4*)kw = oa; *(u32x4*)(kw + 128) = ob;
                ka0 = na0; ka1 = na1; kb0 = nb0; kb1 = nb1;
            }
            __syncthreads();
            const unsigned* ra = KL + (2 * w) * TK_ROW + lane; const unsigned* rb = ra + TK_ROW;
#pragma unroll
            for (int jg = 0; jg < 8; ++jg) {
                if (8 * c + jg < npair) {
#pragma unroll
                    for (int jj = 0; jj < 4; ++jj) { const int j = 4 * jg + jj; keyA[32 * c + j] = ra[64 * j]; keyB[32 * c + j] = rb[64 * j]; }
                } else {
#pragma unroll
                    for (int jj = 0; jj < 4; ++jj) { const int j = 4 * jg + jj; keyA[32 * c + j] = 0u; keyB[32 * c + j] = 0u; }
                }
            }
            __syncthreads();
        } else {
#pragma unroll
            for (int j = 0; j < 32; ++j) { keyA[32 * c + j] = 0u; keyB[32 * c + j] = 0u; }
        }
    }
#undef TK_LOADK
    bf16_t* MK = (bf16_t*)(p.ws + W_MASK);
    topk_select2(keyA, keyB, npair > 8, (npair + 1) >> 1, lim, MK + (size_t)(tok0 + 2 * w) * 256, MK + (size_t)(tok0 + 2 * w + 1) * 256, lane);
}

constexpr int ATT_K = 64 * 144, ATT_V = 64 * 136, ATT_BUF = ATT_K + ATT_V;

template <int MODE, bool SAMPLE>
DEVI void attn_unit(const Params& p, const int b, const int h, const int qt, unsigned char* smem) {
    int tid = threadIdx.x; asm volatile("" : "+v"(tid));
    const int lane = tid & 63, w = tid >> 6, l15 = lane & 15, g = lane >> 4;
    const int tok0 = SAMPLE ? (NTP + b * 32) : (b * 4096 + qt * 256 + 32 * w);
    const int pos0 = SAMPLE ? 2048 : (qt * 256 + 32 * w);
    const bool active = SAMPLE ? (w == 0) : true;
    const int nkt = SAMPLE ? 33 : 4 * (qt + 1);
    const int kt_hi = nkt - 1;
    const bf16_t* Kb = nullptr; const bf16_t* Vb = nullptr; const float* Kc = nullptr; const float* Vc = nullptr; const float* Kn = nullptr; const float* Vn = nullptr;
    if (!SAMPLE) {
        Kb = (const bf16_t*)(p.ws + (MODE == 0 ? W_KAP : W_KBP)) + (size_t)b * 4096 * 512 + h * 64;
        Vb = (const bf16_t*)(p.ws + (MODE == 0 ? W_VAP : W_VBP)) + (size_t)b * 4096 * 512 + h * 64;
    } else {
        Kc = (MODE == 0 ? p.ca_k : p.cb_k) + (size_t)b * 2048 * 512 + h * 64;
        Vc = (MODE == 0 ? p.ca_v : p.cb_v) + (size_t)b * 2048 * 512 + h * 64;
        Kn = p.out + (MODE == 0 ? O_AKS : O_BKS) + (size_t)b * 32 * 512 + h * 64;
        Vn = p.out + (MODE == 0 ? O_AVS : O_BVS) + (size_t)b * 32 * 512 + h * 64;
    }
    const bf16_t* Q = (const bf16_t*)(p.ws + (MODE == 0 ? W_QA : W_QB));
    bf16x8 qf[2][2];
#pragma unroll
    for (int j = 0; j < 2; ++j)
#pragma unroll
        for (int kh = 0; kh < 2; ++kh) qf[j][kh] = *(const bf16x8*)(Q + (size_t)(tok0 + 16 * j + l15) * 512 + h * 64 + 32 * kh + 8 * g);
    f32x4 O[4][2];
#pragma unroll
    for (int dt = 0; dt < 4; ++dt)
#pragma unroll
        for (int j = 0; j < 2; ++j) O[dt][j] = (f32x4){0.f, 0.f, 0.f, 0.f};
    float st_m[2] = {-1e29f, -1e29f};
    float st_l[2] = {MODE == 0 ? 0.f : 1.f, MODE == 0 ? 0.f : 1.f};
    const bf16_t* MK = (const bf16_t*)(p.ws + W_MASK);
    const int limw = SAMPLE ? 2112 : (qt * 256 + 64 * ((w >> 1) + 1));

    u32x4 kr[2], vr[2];
    auto gload = [&](const int kt) {
        if (!SAMPLE) {
            const int s = 64 * kt + (tid >> 3), c = tid & 7;
            kr[0] = *(const u32x4*)(Kb + (size_t)s * 512 + 8 * c);
            if (tid < 256) {
                const int pr = tid >> 3;
                vr[0] = *(const u32x4*)(Vb + (size_t)(64 * kt + 2 * pr) * 512 + 8 * c);
                vr[1] = *(const u32x4*)(Vb + (size_t)(64 * kt + 2 * pr + 1) * 512 + 8 * c);
            }
        } else {
            {
                const int s = 64 * kt + (tid >> 3), c = tid & 7;
                const bool ok = s < 2080;
                const int sc = ok ? s : 2079;
                const float* rp = (sc < 2048) ? Kc + (size_t)sc * 512 : Kn + (size_t)(sc - 2048) * 512;
                f32x4 a0 = *(const f32x4*)(rp + 8 * c), a1 = *(const f32x4*)(rp + 8 * c + 4);
                if (!ok) { a0 = (f32x4){0.f, 0.f, 0.f, 0.f}; a1 = a0; }
                kr[0].x = pk_bf16(a0[0], a0[1]); kr[0].y = pk_bf16(a0[2], a0[3]); kr[0].z = pk_bf16(a1[0], a1[1]); kr[0].w = pk_bf16(a1[2], a1[3]);
            }
            {
                const int pr = tid >> 4, c4 = tid & 15;
                const int s = 64 * kt + 2 * pr;
                const bool ok = s < 2080;
                const int sc = ok ? s : 2078;
                const float* rp = (sc < 2048) ? Vc + (size_t)sc * 512 : Vn + (size_t)(sc - 2048) * 512;
                f32x4 a0 = *(const f32x4*)(rp + 4 * c4), a1 = *(const f32x4*)(rp + 512 + 4 * c4);
                if (!ok) { a0 = (f32x4){0.f, 0.f, 0.f, 0.f}; a1 = a0; }
                vr[0].x = pk_bf16(a0[0], a1[0]); vr[0].y = pk_bf16(a0[1], a1[1]); vr[0].z = pk_bf16(a0[2], a1[2]); vr[0].w = pk_bf16(a0[3], a1[3]);
            }
        }
    };
    auto lstore = [&](const int bufi) {
        unsigned char* Ks = smem + bufi * ATT_BUF; unsigned char* Vs = Ks + ATT_K;
        {
            const int s = tid >> 3, c = tid & 7;
            *(u32x4*)(Ks + s * 144 + c * 16) = kr[0];
        }
        if (!SAMPLE) {
            if (tid < 256) {
                const int pr = tid >> 3, c = tid & 7;
                const unsigned a[4] = {vr[0].x, vr[0].y, vr[0].z, vr[0].w}, bb[4] = {vr[1].x, vr[1].y, vr[1].z, vr[1].w};
#pragma unroll
                for (int i = 0; i < 4; ++i) {
                    const unsigned lo = (a[i] & 0xffffu) | (bb[i] << 16);
                    const unsigned hi2 = (a[i] >> 16) | (bb[i] & 0xffff0000u);
                    *(unsigned*)(Vs + (8 * c + 2 * i) * 136 + pr * 4) = lo;
                    *(unsigned*)(Vs + (8 * c + 2 * i + 1) * 136 + pr * 4) = hi2;
                }
            }
        } else {
            const int pr = tid >> 4, c4 = tid & 15;
            *(unsigned*)(Vs + (4 * c4 + 0) * 136 + pr * 4) = vr[0].x;
            *(unsigned*)(Vs + (4 * c4 + 1) * 136 + pr * 4) = vr[0].y;
            *(unsigned*)(Vs + (4 * c4 + 2) * 136 + pr * 4) = vr[0].z;
            *(unsigned*)(Vs + (4 * c4 + 3) * 136 + pr * 4) = vr[0].w;
        }
    };

    u32x2 mw[2] = {(u32x2){0u, 0u}, (u32x2){0u, 0u}}, mwn[2] = {(u32x2){0u, 0u}, (u32x2){0u, 0u}};
    if (MODE == 0 && active) {
#pragma unroll
        for (int j = 0; j < 2; ++j) mw[j] = *(const u32x2*)(MK + (size_t)(tok0 + 16 * j + l15) * 256);
    }
    gload(MODE == 0 ? 0 : kt_hi);
    lstore(0);
    __syncthreads();
    for (int it = 0; it < nkt; ++it) {
        const int kt = (MODE == 0) ? it : (kt_hi - it);
        if (it + 1 < nkt) gload((MODE == 0) ? (it + 1) : (kt_hi - it - 1));
        const unsigned char* Ks = smem + (it & 1) * ATT_BUF; const unsigned char* Vs = Ks + ATT_K;
        bool work = active;
        if (MODE == 0) work = work && (64 * kt < limw);
        else work = work && (64 * kt < pos0 + 31);
        if (MODE == 0) {
            if (active && it + 1 < nkt && 64 * (it + 1) < limw) {
#pragma unroll
                for (int j = 0; j < 2; ++j) mwn[j] = *(const u32x2*)(MK + (size_t)(tok0 + 16 * j + l15) * 256 + 4 * (it + 1));
            }
        }
        if (work) {
            f32x4 S[4][2];
#pragma unroll
            for (int st = 0; st < 4; ++st) {
                const bf16x8 k0 = *(const bf16x8*)(Ks + (16 * st + l15) * 144 + (8 * g) * 2);
                const bf16x8 k1 = *(const bf16x8*)(Ks + (16 * st + l15) * 144 + (32 + 8 * g) * 2);
#pragma unroll
                for (int j = 0; j < 2; ++j) {
                    f32x4 d = mfma16(k0, qf[j][0], (f32x4){0.f, 0.f, 0.f, 0.f});
                    S[st][j] = mfma16(k1, qf[j][1], d);
                }
            }
            u32x4 pf[2][2];
            if (MODE == 0) {
                float mnew[2], alpha[2];
#pragma unroll
                for (int j = 0; j < 2; ++j) {
                    float mx = -1e30f;
#pragma unroll
                    for (int st = 0; st < 4; ++st) {
                        const unsigned word = (st < 2) ? mw[j].x : mw[j].y;
                        const unsigned nib = word >> (16 * (st & 1) + 4 * g);
#pragma unroll
                        for (int r = 0; r < 4; ++r) {
                            const int sel = __builtin_amdgcn_sbfe(nib, r, 1);
                            const unsigned bits = (__float_as_uint(S[st][j][r]) & (unsigned)sel) | (0xF149F2CAu & ~(unsigned)sel);
                            S[st][j][r] = __uint_as_float(bits);
                        }
                        mx = fmaxf(mx, fmaxf(fmaxf(S[st][j][0], S[st][j][1]), fmaxf(S[st][j][2], S[st][j][3])));
                    }
                    mx = fmaxf(mx, shx(mx, 16)); mx = fmaxf(mx, shx(mx, 32));
                    mnew[j] = (mx > st_m[j] + 8.0f) ? mx : st_m[j];
                    alpha[j] = __builtin_amdgcn_exp2f(st_m[j] - mnew[j]);
                }
#pragma unroll
                for (int j = 0; j < 2; ++j) {
                    float ps = 0.f;
#pragma unroll
                    for (int st = 0; st < 4; ++st)
#pragma unroll
                        for (int r = 0; r < 4; ++r) { const float pv = __builtin_amdgcn_exp2f(S[st][j][r] - mnew[j]);   S[st][j][r] = pv; ps += pv; }
                    st_l[j] = st_l[j] * alpha[j] + ps;
                    st_m[j] = mnew[j];
                }
                if (!__all(alpha[0] == 1.0f && alpha[1] == 1.0f)) {
#pragma unroll
                    for (int j = 0; j < 2; ++j)
#pragma unroll
                        for (int dt = 0; dt < 4; ++dt) O[dt][j] = O[dt][j] * alpha[j];
                }
            } else {
#pragma unroll
                for (int j = 0; j < 2; ++j) {
                    const int t = pos0 + 16 * j + l15;
                    float P = st_l[j];
#pragma unroll
                    for (int st = 3; st >= 0; --st) {
                        const int sb = 64 * kt + 16 * st + 4 * g;
                        float sg[4], om[4];
#pragma unroll
                        for (int r = 0; r < 4; ++r) {
                            const int sbits = __float_as_int(S[st][j][r]);
                            const float uu = __builtin_amdgcn_exp2f(__int_as_float(sbits < 0x42e6d4ca ? sbits : 0x42e6d4ca));
                            const float sgm = __builtin_amdgcn_rcpf(1.0f + uu);
                            const bool valid = (sb + r) < t;
                            sg[r] = valid ? sgm : 0.f;
                            om[r] = valid ? (uu * sgm) : 1.f;
                        }
                        const float x2 = om[3], x1 = x2 * om[2], x0 = x1 * om[1], tot = x0 * om[0];
                        const float a_ = shx(tot, 16);
                        const float pair = tot * a_;
                        const float b_ = shx(pair, 32);
                        const float cross = (g == 0) ? (a_ * b_) : (g == 1) ? b_ : (g == 2) ? a_ : 1.f;
                        const float base = P * cross;
                        S[st][j][0] = sg[0] * (base * x0); S[st][j][1] = sg[1] * (base * x1); S[st][j][2] = sg[2] * (base * x2); S[st][j][3] = sg[3] * base;
                        P *= pair * b_;
                    }
                    st_l[j] = P;
                }
            }
#pragma unroll
            for (int j = 0; j < 2; ++j)
#pragma unroll
                for (int ks = 0; ks < 2; ++ks) {
                    pf[j][ks].x = pk_bf16(S[2 * ks][j][0], S[2 * ks][j][1]); pf[j][ks].y = pk_bf16(S[2 * ks][j][2], S[2 * ks][j][3]);
                    pf[j][ks].z = pk_bf16(S[2 * ks + 1][j][0], S[2 * ks + 1][j][1]); pf[j][ks].w = pk_bf16(S[2 * ks + 1][j][2], S[2 * ks + 1][j][3]);
                }
#pragma unroll
            for (int dt = 0; dt < 4; ++dt)
#pragma unroll
                for (int ks = 0; ks < 2; ++ks) {
                    const u32x2 v0 = *(const u32x2*)(Vs + (16 * dt + l15) * 136 + (32 * ks + 4 * g) * 2);
                    const u32x2 v1 = *(const u32x2*)(Vs + (16 * dt + l15) * 136 + (32 * ks + 16 + 4 * g) * 2);
                    const u32x4 vv = (u32x4){v0.x, v0.y, v1.x, v1.y};
                    const bf16x8 vf = __builtin_bit_cast(bf16x8, vv);
#pragma unroll
                    for (int j = 0; j < 2; ++j) O[dt][j] = mfma16(vf, __builtin_bit_cast(bf16x8, pf[j][ks]), O[dt][j]);
                }
        }
        if (it + 1 < nkt) lstore((it + 1) & 1);
        if (MODE == 0) { mw[0] = mwn[0]; mw[1] = mwn[1]; }
        if (MODE == 1) {
            const int wdone = (!active) || __all((st_l[0] == 0.f) && (st_l[1] == 0.f));
            volatile int* flags = (volatile int*)(smem + 2 * ATT_BUF) + (it & 1) * 8;
            if (lane == 0) flags[w] = wdone;
            __syncthreads();
            const int alld = flags[0] & flags[1] & flags[2] & flags[3] & flags[4] & flags[5] & flags[6] & flags[7];
            if (alld) break;
        } else {
            __syncthreads();
        }
    }
    if (active) {
        const bf16_t* SU = (const bf16_t*)(p.ws + (MODE == 0 ? W_SUA : W_SUB));
        bf16_t* OAB = (bf16_t*)(p.ws + W_OAB);
#pragma unroll
        for (int j = 0; j < 2; ++j) {
            float inv = 1.0f;
            if (MODE == 0) { float l = st_l[j]; l += shx(l, 16); l += shx(l, 32); inv = (l > 0.f) ? __builtin_amdgcn_rcpf(l) : 0.f; }
            const int tok = tok0 + 16 * j + l15;
#pragma unroll
            for (int dt = 0; dt < 4; ++dt) {
                const int col = h * 64 + 16 * dt + 4 * g;
                const u32x2 su = *(const u32x2*)(SU + (size_t)tok * 512 + col);
                f32x4 o = O[dt][j] * inv;
                u32x2 ov; ov.x = pk_bf16(o[0] * bf_lo(su.x), o[1] * bf_hi(su.x)); ov.y = pk_bf16(o[2] * bf_lo(su.y), o[3] * bf_hi(su.y));
                *(u32x2*)(OAB + (MODE == 0 ? (size_t)0 : (size_t)NTOK * 512) + (size_t)tok * 512 + col) = ov;
            }
        }
    }
    __syncthreads();
}

template <int PH>
DEVI void run_phase(const Params& p, unsigned char* smem) {
    const int nb = gridDim.x, bid = blockIdx.x;
    PG8_LAS unsigned char* lds = (PG8_LAS unsigned char*)smem;
    if (PH == 0) {
        phase0(p, smem);
    } else if (PH == 1) {
        EpiProj epi; epi.pp = &p;
        pg8::Gemm g{(const bf16_t*)(p.ws + W_XN), (const bf16_t*)(p.ws + W_WINT), nullptr, nullptr, 1024};
        OrderP1 S; S.init();
        pg8::gemm_phase(lds, g, S, epi);
    } else if (PH == 2) {
        for (int u = bid; u < 2112; u += nb) topk_unit(p, u, smem);
        if (nb == 256) {
            if (bid < 64) { for (int v = 2 * bid; v < 2 * bid + 2; ++v) attn_unit<1, false>(p, v >> 7, (v >> 4) & 7, 15 - (v & 15), smem); }
            else { for (int v = 128 + (bid - 64); v < 1024; v += 192) attn_unit<1, false>(p, v >> 7, (v >> 4) & 7, 15 - (v & 15), smem); }
        } else {
            for (int v = bid; v < 1024; v += nb) attn_unit<1, false>(p, v >> 7, (v >> 4) & 7, 15 - (v & 15), smem);
        }
        for (int v = bid; v < 256; v += nb) attn_unit<1, true>(p, v >> 3, v & 7, 0, smem);
    } else if (PH == 3) {
        for (int su0 = bid; su0 < 256; su0 += nb) {
            const int su = (nb == 256) ? (((su0 & 7) << 5) | (su0 >> 3)) : su0;
            const int b = su >> 5, h = (su >> 2) & 7, x = su & 3;
            for (int k = 0; k < 4; ++k) {
                const int qt = (k == 0) ? 15 - x : (k == 1) ? 8 + x : (k == 2) ? 7 - x : x;
                attn_unit<0, false>(p, b, h, qt, smem);
            }
            attn_unit<0, true>(p, su >> 3, su & 7, 0, smem);
        }
    } else if (PH == 4) {
        for (int t = bid; t < 256; t += nb) mini_mix_tile(p, t);
        EpiMix epi; epi.pp = &p;
        const bf16_t* OA = (const bf16_t*)(p.ws + W_OAB); const bf16_t* WAT = (const bf16_t*)(p.ws + W_WABT);
        pg8::Gemm g{OA, WAT, OA + (size_t)NTOK * 512, WAT + 1024 * 512, 512};
        OrderP4 S; S.init(true);
        pg8::gemm_phase(lds, g, S, epi);
    } else if (PH == 5) {
        for (int t = bid; t < 256; t += nb) mini_y_tile(p, t);
        EpiY epi; epi.pp = &p;
        pg8::Gemm g{(const bf16_t*)(p.ws + W_XN), (const bf16_t*)(p.ws + W_WOT), nullptr, nullptr, 1024};
        OrderP4 S; S.init(false);
        pg8::gemm_phase(lds, g, S, epi);
    }
}

#define XB_TMO      128
#define XB_XCNT(j)  (256  + 64 * (j))
#define XB_XSUB(j)  (1280 + 64 * (j))
#define XB_XGEN(j)  (2304 + 64 * (j))
#define XB_TOP      3328
#define XB_TOPGEN   3392
#define XB_SPIN_CAP (1u << 18)
DEVI unsigned xb_ld(unsigned* p)              { return __hip_atomic_load(p, __ATOMIC_RELAXED, __HIP_MEMORY_SCOPE_AGENT); }
DEVI unsigned xb_add(unsigned* p, unsigned v) { return __hip_atomic_fetch_add(p, v, __ATOMIC_RELAXED, __HIP_MEMORY_SCOPE_AGENT); }
DEVI unsigned xb_xcc_id() { return (unsigned)__builtin_amdgcn_s_getreg((3 << 11) | 20) & 0xFu; }
#define XB_SPIN(cond, bar) do { unsigned _sp = 0; while (cond) { __builtin_amdgcn_s_sleep(1); \
    if ((++_sp & 255u) == 0u) { if (xb_ld(&(bar)[XB_TMO])) break; if (_sp > XB_SPIN_CAP) { atomicAdd(&(bar)[XB_TMO], 1u); break; } } } } while (0)
struct XcdBarrier { unsigned* bar; unsigned x; volatile PG8_LAS unsigned* st; };
DEVI XcdBarrier xcd_barrier_post(unsigned* bar, volatile PG8_LAS unsigned* st) {
    XcdBarrier b; b.bar = bar; b.x = xb_xcc_id(); b.st = st;
    if (threadIdx.x == 0) (void)xb_add(&bar[XB_XCNT(b.x)], 1u);
    return b;
}
DEVI void xcd_barrier_complete(unsigned* bar, unsigned x, unsigned& nloc, unsigned& nx) {
    const unsigned G = gridDim.x * gridDim.y * gridDim.z;
    unsigned sum, cnt, mine, sp = 0u;
    for (;;) {
        sum = 0u; cnt = 0u; mine = 0u;
#pragma unroll
        for (unsigned j = 0; j < 16; ++j) { const unsigned c = xb_ld(&bar[XB_XCNT(j)]); sum += c; cnt += (c > 0u) ? 1u : 0u; mine = (j == x) ? c : mine; }
        if (sum == G) break;
        __builtin_amdgcn_s_sleep(1);
        if ((++sp & 255u) == 0u) { if (xb_ld(&bar[XB_TMO])) break; if (sp > XB_SPIN_CAP) { atomicAdd(&bar[XB_TMO], 1u); break; } }
    }
    nloc = mine > 0u ? mine : 1u; nx = cnt > 0u ? cnt : 1u;
}
DEVI void xcd_barrier(const XcdBarrier& b) {
    asm volatile("s_waitcnt vmcnt(0)" ::: "memory");
    __syncthreads();
    if (threadIdx.x == 0) {
        unsigned* bar = b.bar;
        __builtin_amdgcn_s_waitcnt(0);
        unsigned nloc = b.st[0], nx = b.st[1];
        if (nloc == 0u) { xcd_barrier_complete(bar, b.x, nloc, nx); b.st[0] = nloc; b.st[1] = nx; }
        const unsigned old = xb_add(&bar[XB_XSUB(b.x)], 1u);
        const unsigned gen = old / nloc;
        if (old + 1u == (gen + 1u) * nloc) {
            __builtin_amdgcn_fence(__ATOMIC_RELEASE, "agent");
            asm volatile("s_waitcnt vmcnt(0)" ::: "memory");
            const unsigned og = xb_add(&bar[XB_TOP], 1u);
            const unsigned tg = og / nx;
            if (og + 1u == (tg + 1u) * nx) xb_add(&bar[XB_TOPGEN], 1u);
            else XB_SPIN(xb_ld(&bar[XB_TOPGEN]) == tg, bar);
            __builtin_amdgcn_fence(__ATOMIC_ACQUIRE, "agent");
            xb_add(&bar[XB_XGEN(b.x)], 1u);
            asm volatile("s_waitcnt vmcnt(0)" ::: "memory");
        } else {
            XB_SPIN(xb_ld(&bar[XB_XGEN(b.x)]) == gen, bar);
            __builtin_amdgcn_fence(__ATOMIC_ACQUIRE, "agent");
            asm volatile("s_waitcnt vmcnt(0)" ::: "memory");
        }
    }
    __syncthreads();
}

template <int LO, int HI>
__global__ void __launch_bounds__(NTHREADS) fwd_kernel(const Params p) {
    extern __shared__ __align__(16) unsigned char smem[];
    XcdBarrier xb; xb.bar = (unsigned*)(p.ws + W_BAR); xb.x = 0; xb.st = (volatile PG8_LAS unsigned*)((PG8_LAS unsigned char*)smem + LDS_XB);
    if (LO < HI) {
        if (threadIdx.x == 0) { xb.st[0] = 0u; xb.st[1] = 0u; }
        __syncthreads();
        xb = xcd_barrier_post((unsigned*)(p.ws + W_BAR), xb.st);
    }
    if (LO <= 0 && 0 <= HI) { run_phase<0>(p, smem); if (0 < HI) { if (p.out == nullptr) cg::this_grid().sync(); else xcd_barrier(xb); } }
    if (LO <= 1 && 1 <= HI) { run_phase<1>(p, smem); if (1 < HI) xcd_barrier(xb); }
    if (LO <= 2 && 2 <= HI) { run_phase<2>(p, smem); if (2 < HI) xcd_barrier(xb); }
    if (LO <= 3 && 3 <= HI) { run_phase<3>(p, smem); if (3 < HI) xcd_barrier(xb); }
    if (LO <= 4 && 4 <= HI) { run_phase<4>(p, smem); if (4 < HI) xcd_barrier(xb); }
    if (LO <= 5 && 5 <= HI) { run_phase<5>(p, smem); }
}

#ifndef MK_COOP
#define MK_COOP 1
#endif

template <int LO, int HI>
static void launch_range(const Params& p, int grid, hipStream_t stream, bool coop) {
    auto kfn = fwd_kernel<LO, HI>;
    static bool attr_set = false;
    if (!attr_set) { (void)hipFuncSetAttribute((const void*)kfn, hipFuncAttributeMaxDynamicSharedMemorySize, LDS_BYTES); attr_set = true; }
    if (coop) {
        Params pl = p;
        void* args[] = {&pl};
        hipError_t e = hipLaunchCooperativeKernel((const void*)kfn, dim3(grid), dim3(NTHREADS), args, LDS_BYTES, stream);
        if (e != hipSuccess) fprintf(stderr, "cooperative launch failed: %s (grid %d)\n", hipGetErrorString(e), grid);
    } else {
        hipLaunchKernelGGL(kfn, dim3(grid), dim3(NTHREADS), LDS_BYTES, stream, p);
    }
}

extern "C" void kernel_launch(void* const* d_in, const int* in_sizes, int n_in, void* d_out, int out_size, void* d_ws, size_t ws_size, hipStream_t stream) {
    (void)in_sizes; (void)n_in; (void)out_size;
    static int grid_blocks = 0;
    if (!grid_blocks) {
        int dev = 0, cus = 0;
        (void)hipGetDevice(&dev);
        (void)hipDeviceGetAttribute(&cus, hipDeviceAttributeMultiprocessorCount, dev);
        grid_blocks = cus > 0 ? cus : 256;
        if (ws_size < W_END) fprintf(stderr, "workspace too small: %zu < %zu\n", ws_size, (size_t)W_END);
    }
    Params p{};
    p.x_p = (const float*)d_in[0]; p.x_s = (const float*)d_in[1]; p.ca_k = (const float*)d_in[2]; p.ca_v = (const float*)d_in[3];
    p.c_ik = (const float*)d_in[4]; p.cb_k = (const float*)d_in[5]; p.cb_v = (const float*)d_in[6]; p.norm_g = (const float*)d_in[7];
    p.w_in = (const float*)d_in[8]; p.qn_g = (const float*)d_in[9]; p.kn_g = (const float*)d_in[10]; p.ikn_g = (const float*)d_in[11];
    p.w_a = (const float*)d_in[12]; p.w_b = (const float*)d_in[13]; p.w_o = (const float*)d_in[14];
    p.out = (float*)d_out; p.ws = (unsigned char*)d_ws;
#if MK_COOP
    (void)hipMemsetAsync((unsigned char*)d_ws + W_BAR, 0, 16384, stream);
    launch_range<0, 5>(p, grid_blocks, stream, true);
#else
    launch_range<0, 0>(p, grid_blocks, stream, false);
    launch_range<1, 1>(p, grid_blocks, stream, false);
    launch_range<2, 2>(p, grid_blocks, stream, false);
    launch_range<3, 3>(p, grid_blocks, stream, false);
    launch_range<4, 4>(p, grid_blocks, stream, false);
    launch_range<5, 5>(p, grid_blocks, stream, false);
#endif
}
```
